# Optimizing an MI355X kernel written in HIP

```python
import math
import jax, jax.numpy as jnp
from jax import lax
import numpy as np

D_MODEL = 2048
BATCH = 4
SEQ = 2048
DEPTH = 2

CHUNK = 64
EPS = 1e-6
NEG = -1e30
A_HEADS = 8
A_HEAD_DIM = 64
A_LEFT_CHUNKS = 8
A_MAX_REL = 128
B_HEADS = 8
B_HEAD_DIM = 64
B_LATENT = 128
IDX_HEADS = 8
IDX_DIM = 64
TOPK_MAX = 256
Q_BLOCK = 128
C_Q_HEADS = 16
C_KV_HEADS = 2
C_HEAD_DIM = 64
C_WINDOW = 128
C_LEFT_CHUNKS = C_WINDOW // CHUNK
T5_BUCKETS = 32
T5_MAX_DIST = 256
MEM_LEN = 256
MEM_HEADS = 4
MEM_HEAD_DIM = 128
MEM_W = MEM_HEADS * MEM_HEAD_DIM
D_FF = 5504
CONV_W = 3

A_W = A_HEADS * A_HEAD_DIM
B_W = B_HEADS * B_HEAD_DIM
C_W = C_Q_HEADS * C_HEAD_DIM
C_KV_W = C_KV_HEADS * C_HEAD_DIM
C_GROUP = C_Q_HEADS // C_KV_HEADS
N_BRANCH = 3
MIX_W = A_W + B_W + C_W
IN_SIZES = (A_W, A_W, A_W, B_W, B_LATENT, IDX_HEADS * IDX_DIM, IDX_DIM, IDX_HEADS, C_W, C_KV_W, C_KV_W, N_BRANCH * D_MODEL)
IN_W = 3 * A_W + B_W + B_LATENT + IDX_HEADS * IDX_DIM + IDX_DIM + IDX_HEADS + C_W + 2 * C_KV_W + N_BRANCH * D_MODEL

kernel_name = 'hybrid_chunk_streaming_encoder'


def rmsnorm(x, g):
    xf = x.astype(jnp.float32)
    y = xf * lax.rsqrt(jnp.mean(xf * xf, axis=-1, keepdims=True) + EPS)
    return (y * g.astype(jnp.float32)).astype(x.dtype)


def split_cols(t, sizes):
    offs = np.cumsum(sizes)[:-1].tolist()
    return jnp.split(t, offs, axis=-1)


def t5_bucket(rel):
    half = T5_BUCKETS // 2
    max_exact = half // 2
    sign = jnp.where(rel > 0, half, 0)
    d = jnp.abs(rel)
    d_f = jnp.maximum(d, 1).astype(jnp.float32)
    large = max_exact + (jnp.log(d_f / max_exact) / math.log(T5_MAX_DIST / max_exact) * (half - max_exact)).astype(jnp.int32)
    large = jnp.minimum(large, half - 1)
    return sign + jnp.where(d < max_exact, d, large)


def chunk_band(t, n_left):
    b, s = t.shape[:2]
    nc = s // CHUNK
    tc = t.reshape((b, nc, CHUNK) + t.shape[2:])
    tp = jnp.pad(tc, [(0, 0), (n_left, 0)] + [(0, 0)] * (tc.ndim - 2))
    return jnp.concatenate([tp[:, j:j + nc] for j in range(n_left + 1)], axis=2)


def band_valid(nc, n_left):
    band = (n_left + 1) * CHUNK
    key_chunk = jnp.arange(nc)[:, None] - n_left + (jnp.arange(band) // CHUNK)[None, :]
    return key_chunk >= 0


def chunk_attention_a(q, k, v, rel_bias):
    b, s = q.shape[:2]
    nc = s // CHUNK
    band = (A_LEFT_CHUNKS + 1) * CHUNK
    qc = q.reshape(b, nc, CHUNK, A_HEADS, A_HEAD_DIM)
    kb = chunk_band(k, A_LEFT_CHUNKS)
    vb = chunk_band(v, A_LEFT_CHUNKS)
    logits = jnp.einsum('bcihd,bcjhd->bchij', qc, kb).astype(jnp.float32) * (A_HEAD_DIM ** -0.5)
    rel = A_LEFT_CHUNKS * CHUNK + jnp.arange(CHUNK)[:, None] - jnp.arange(band)[None, :]
    idx = jnp.clip(rel, -A_MAX_REL, A_MAX_REL) + A_MAX_REL
    bias = jnp.transpose(rel_bias[idx], (2, 0, 1)).astype(jnp.float32)
    logits = logits + bias[None, None]
    valid = band_valid(nc, A_LEFT_CHUNKS)
    logits = jnp.where(valid[None, :, None, None, :], logits, NEG)
    p = jax.nn.softmax(logits, axis=-1).astype(v.dtype)
    o = jnp.einsum('bchij,bcjhd->bcihd', p, vb)
    return o.reshape(b, s, A_W)


def dsa_attention_b(q, ckv, qi, ki, wi, w_uk, w_uv, t5_b):
    b, s = q.shape[:2]
    nb = s // Q_BLOCK
    topk = min(TOPK_MAX, s // 4)
    q_lat = jnp.einsum('bshd,hcd->bshc', q, w_uk)
    wi_s = wi * (IDX_HEADS ** -0.5)
    kpos = jnp.arange(s, dtype=jnp.int32)

    def to_blocks(t):
        return jnp.moveaxis(t.reshape((b, nb, Q_BLOCK) + t.shape[2:]), 1, 0)

    def block(args):
        ql, qib, wib, qpos = args
        dots = jnp.einsum('bthd,bsd->bths', qib, ki).astype(jnp.float32) * (IDX_DIM ** -0.5)
        score = jnp.einsum('bths,bth->bts', jax.nn.relu(dots), wib.astype(jnp.float32))
        adm = (kpos // CHUNK)[None, :] <= (qpos // CHUNK)[:, None]
        score = jnp.where(adm[None], score, NEG)
        _, idx = lax.top_k(score, topk)
        valid = (idx // CHUNK) <= (qpos // CHUNK)[None, :, None]
        c_sel = jax.vmap(lambda c, i: c[i])(ckv, idx)
        bias = t5_b[t5_bucket(idx - qpos[None, :, None])]
        logits = jnp.einsum('bthc,btkc->bthk', ql, c_sel).astype(jnp.float32) * (B_HEAD_DIM ** -0.5)
        logits = logits + jnp.moveaxis(bias, -1, 2).astype(jnp.float32)
        logits = jnp.where(valid[:, :, None, :], logits, NEG)
        p = jax.nn.softmax(logits, axis=-1).astype(ckv.dtype)
        o_lat = jnp.einsum('bthk,btkc->bthc', p, c_sel)
        return jnp.einsum('bthc,hcd->bthd', o_lat, w_uv).reshape(b, Q_BLOCK, B_W)

    out = lax.map(block, (to_blocks(q_lat), to_blocks(qi), to_blocks(wi_s), kpos.reshape(nb, Q_BLOCK)))
    return jnp.moveaxis(out, 0, 1).reshape(b, s, B_W)


def sliding_sink_attention_c(q, k, v, t5_c, sinks):
    b, s = q.shape[:2]
    nc = s // CHUNK
    band = (C_LEFT_CHUNKS + 1) * CHUNK
    qc = q.reshape(b, nc, CHUNK, C_KV_HEADS, C_GROUP, C_HEAD_DIM)
    kb = chunk_band(k, C_LEFT_CHUNKS)
    vb = chunk_band(v, C_LEFT_CHUNKS)
    logits = jnp.einsum('bcikgd,bcjkd->bckgij', qc, kb).astype(jnp.float32) * (C_HEAD_DIM ** -0.5)
    rel = jnp.arange(band)[None, :] - (C_LEFT_CHUNKS * CHUNK + jnp.arange(CHUNK)[:, None])
    bias = jnp.transpose(t5_c[t5_bucket(rel)], (2, 0, 1)).reshape(C_KV_HEADS, C_GROUP, CHUNK, band)
    logits = logits + bias[None, None].astype(jnp.float32)
    valid = band_valid(nc, C_LEFT_CHUNKS)
    logits = jnp.where(valid[None, :, None, None, None, :], logits, NEG)
    sk = sinks.reshape(C_KV_HEADS, C_GROUP).astype(jnp.float32)[None, None, :, :, None, None]
    sk = jnp.broadcast_to(sk, logits.shape[:-1] + (1,))
    p = jax.nn.softmax(jnp.concatenate([logits, sk], axis=-1), axis=-1)[..., :-1].astype(v.dtype)
    o = jnp.einsum('bckgij,bcjkd->bcikgd', p, vb)
    return o.reshape(b, s, C_W)


def hybrid_mixer(h, t5_table, w_in, a_rel_bias, ckv_gain, w_uk, w_uv, sinks, w_branch, w_o):
    b, s, _ = h.shape
    qa, ka, va, qb, ckv, qi, ki, wi, qc, kc, vc, gl = split_cols(h @ w_in, IN_SIZES)
    oa = chunk_attention_a(qa.reshape(b, s, A_HEADS, A_HEAD_DIM), ka.reshape(b, s, A_HEADS, A_HEAD_DIM),
                           va.reshape(b, s, A_HEADS, A_HEAD_DIM), a_rel_bias)
    ob = dsa_attention_b(qb.reshape(b, s, B_HEADS, B_HEAD_DIM), rmsnorm(ckv, ckv_gain),
                         qi.reshape(b, s, IDX_HEADS, IDX_DIM), ki, wi, w_uk, w_uv, t5_table[:, :B_HEADS])
    oc = sliding_sink_attention_c(qc.reshape(b, s, C_Q_HEADS, C_HEAD_DIM), kc.reshape(b, s, C_KV_HEADS, C_HEAD_DIM),
                                  vc.reshape(b, s, C_KV_HEADS, C_HEAD_DIM), t5_table[:, B_HEADS:], sinks)
    gates = jax.nn.sigmoid(gl.astype(jnp.float32)).astype(h.dtype).reshape(b, s, N_BRANCH, D_MODEL)
    wa, wb, wc = jnp.split(w_branch, [A_W, A_W + B_W], axis=0)
    merged = gates[:, :, 0] * (oa @ wa) + gates[:, :, 1] * (ob @ wb) + gates[:, :, 2] * (oc @ wc)
    return merged @ w_o


def memory_xattn(h, mem_n, w_mq, w_mkv, w_mo):
    b, s, _ = h.shape
    m = mem_n.shape[1]
    q = (h @ w_mq).reshape(b, s, MEM_HEADS, MEM_HEAD_DIM)
    k, v = jnp.split((mem_n @ w_mkv).reshape(b, m, 2 * MEM_HEADS, MEM_HEAD_DIM), 2, axis=2)
    logits = jnp.einsum('bshd,bmhd->bhsm', q, k).astype(jnp.float32) * (MEM_HEAD_DIM ** -0.5)
    p = jax.nn.softmax(logits, axis=-1).astype(v.dtype)
    o = jnp.einsum('bhsm,bmhd->bshd', p, v).reshape(b, s, MEM_W)
    return o @ w_mo


def conv_ffn(h, w_up, conv_w, conv_b, w_down):
    s = h.shape[1]
    u = h @ w_up
    up = jnp.pad(u, ((0, 0), (CONV_W - 1, 0), (0, 0)))
    acc = conv_b + up[:, 0:s] * conv_w[0]
    for j in range(1, CONV_W):
        acc = acc + up[:, j:j + s] * conv_w[j]
    gate, val = jnp.split(acc, 2, axis=-1)
    return (jax.nn.gelu(gate) * val) @ w_down


def setup_inputs(seed: int = 0) -> dict:
    key = jax.random.key(seed)
    ks = jax.random.split(key, 22)
    f32 = jnp.float32

    def nrm(k, shape, scale):
        return jax.random.normal(k, shape, f32) * scale

    return {
        'x': nrm(ks[0], (BATCH, SEQ, D_MODEL), 1.0),
        'mem': nrm(ks[1], (BATCH, MEM_LEN, D_MODEL), 1.0),
        't5_table': nrm(ks[2], (T5_BUCKETS, B_HEADS + C_Q_HEADS), 0.1),
        'norm_gains': 1.0 + nrm(ks[3], (DEPTH, 6, D_MODEL), 0.05),
        'w_in': nrm(ks[4], (DEPTH, D_MODEL, IN_W), D_MODEL ** -0.5),
        'a_rel_bias': nrm(ks[5], (DEPTH, 2 * A_MAX_REL + 1, A_HEADS), 0.1),
        'ckv_gain': 1.0 + nrm(ks[6], (DEPTH, B_LATENT), 0.05),
        'w_uk': nrm(ks[7], (DEPTH, B_HEADS, B_LATENT, B_HEAD_DIM), B_LATENT ** -0.5),
        'w_uv': nrm(ks[8], (DEPTH, B_HEADS, B_LATENT, B_HEAD_DIM), B_LATENT ** -0.5),
        'sinks': nrm(ks[9], (DEPTH, C_Q_HEADS), 0.5),
        'w_branch': nrm(ks[10], (DEPTH, MIX_W, D_MODEL), A_W ** -0.5),
        'w_o': nrm(ks[11], (DEPTH, D_MODEL, D_MODEL), D_MODEL ** -0.5),
        'mem_gain': 1.0 + nrm(ks[12], (DEPTH, D_MODEL), 0.05),
        'w_mq': nrm(ks[13], (DEPTH, D_MODEL, MEM_W), D_MODEL ** -0.5),
        'w_mkv': nrm(ks[14], (DEPTH, D_MODEL, 2 * MEM_W), D_MODEL ** -0.5),
        'w_mo': nrm(ks[15], (DEPTH, MEM_W, D_MODEL), MEM_W ** -0.5),
        'w_up': nrm(ks[16], (DEPTH, D_MODEL, 2 * D_FF), D_MODEL ** -0.5),
        'conv_w': nrm(ks[17], (DEPTH, CONV_W, 2 * D_FF), CONV_W ** -0.5),
        'conv_b': nrm(ks[18], (DEPTH, 2 * D_FF), 0.02),
        'w_down': nrm(ks[19], (DEPTH, D_FF, D_MODEL), D_FF ** -0.5),
    }


def reference(x, mem, t5_table, norm_gains, w_in, a_rel_bias, ckv_gain, w_uk, w_uv, sinks, w_branch, w_o,
              mem_gain, w_mq, w_mkv, w_mo, w_up, conv_w, conv_b, w_down):
    for l in range(DEPTH):
        g = norm_gains[l]
        h = rmsnorm(x, g[0])
        y = hybrid_mixer(h, t5_table, w_in[l], a_rel_bias[l], ckv_gain[l], w_uk[l], w_uv[l], sinks[l], w_branch[l], w_o[l])
        x = x + rmsnorm(y, g[1])
        h = rmsnorm(x, g[2])
        y = memory_xattn(h, rmsnorm(mem, mem_gain[l]), w_mq[l], w_mkv[l], w_mo[l])
        x = x + rmsnorm(y, g[3])
        h = rmsnorm(x, g[4])
        y = conv_ffn(h, w_up[l], conv_w[l], conv_b[l], w_down[l])
        x = x + rmsnorm(y, g[5])
    return x
```

```cpp
#include <hip/hip_runtime.h>
#include <cstdio>
#include <cstdint>
#include <cmath>

constexpr int DM = 2048, NBATCH = 4, SEQ = 2048, MROWS = NBATCH * SEQ, DEPTH = 2;
constexpr int CHUNK = 64;
constexpr float EPS = 1e-6f;
constexpr int A_HEADS = 8, A_LEFT = 8, A_MAXREL = 128;
constexpr int B_HEADS = 8, B_LAT = 128, IDX_HEADS = 8, IDX_DIM = 64, TOPK = 256;
constexpr int C_QH = 16, C_KVH = 2, C_LEFT = 2;
constexpr int MEM_LEN = 256, MEM_HEADS = 4, MEM_HD = 128, MEM_W = 512;
constexpr int DFF = 5504;
constexpr int IN_W = 10184;
constexpr int O_QA = 0, O_KA = 512, O_VA = 1024, O_QB = 1536, O_CKV = 2048, O_QI = 2176, O_KI = 2688, O_WI = 2752, O_QC = 2760, O_KC = 3784, O_VC = 3912, O_GL = 4040;
constexpr int NT5 = 24;

__device__ __forceinline__ int t5_bucket(int rel) {
    const int d = rel < 0 ? -rel : rel;
    const int b = d < 8 ? d : d < 13 ? 8 : d < 20 ? 9 : d < 30 ? 10 : d < 46 ? 11 : d < 70 ? 12 : d < 108 ? 13 : d < 166 ? 14 : 15;
    return b + (rel > 0 ? 16 : 0);
}
__device__ __forceinline__ float wave_sum(float v) {
#pragma unroll
    for (int o = 1; o < 64; o <<= 1) v += __shfl_xor(v, o);
    return v;
}

__device__ __forceinline__ float block_sum_256(float v, float* red) {
    v = wave_sum(v);
    const int w = threadIdx.x >> 6;
    __syncthreads();
    if ((threadIdx.x & 63) == 0) red[w] = v;
    __syncthreads();
    return red[0] + red[1] + red[2] + red[3];
}
__global__ void __launch_bounds__(256) k_rmsnorm(const float* __restrict__ in, const float* __restrict__ g, float* __restrict__ out) {
    __shared__ float red[4];
    const size_t row = blockIdx.x;
    const float4* p = (const float4*)(in + row * DM);
    float4 a = p[threadIdx.x], b = p[threadIdx.x + 256];
    float ss = a.x * a.x + a.y * a.y + a.z * a.z + a.w * a.w + b.x * b.x + b.y * b.y + b.z * b.z + b.w * b.w;
    ss = block_sum_256(ss, red);
    const float r = 1.0f / sqrtf(ss * (1.0f / DM) + EPS);
    const float4 ga = ((const float4*)g)[threadIdx.x], gb = ((const float4*)g)[threadIdx.x + 256];
    float4* o = (float4*)(out + row * DM);
    o[threadIdx.x] = make_float4(a.x * r * ga.x, a.y * r * ga.y, a.z * r * ga.z, a.w * r * ga.w);
    o[threadIdx.x + 256] = make_float4(b.x * r * gb.x, b.y * r * gb.y, b.z * r * gb.z, b.w * r * gb.w);
}
__global__ void __launch_bounds__(256) k_resnorm(const float* xin, const float* y, const float* __restrict__ g1, float* xout,
                                                  const float* __restrict__ g2, float* hout) {
    __shared__ float red[4];
    const size_t row = blockIdx.x;
    const float4* py = (const float4*)(y + row * DM);
    float4 a = py[threadIdx.x], b = py[threadIdx.x + 256];
    float ss = a.x * a.x + a.y * a.y + a.z * a.z + a.w * a.w + b.x * b.x + b.y * b.y + b.z * b.z + b.w * b.w;
    ss = block_sum_256(ss, red);
    const float r = 1.0f / sqrtf(ss * (1.0f / DM) + EPS);
    const float4 ga = ((const float4*)g1)[threadIdx.x], gb = ((const float4*)g1)[threadIdx.x + 256];
    const float4* px = (const float4*)(xin + row * DM);
    float4 xa = px[threadIdx.x], xb = px[threadIdx.x + 256];
    xa.x += a.x * r * ga.x; xa.y += a.y * r * ga.y; xa.z += a.z * r * ga.z; xa.w += a.w * r * ga.w;
    xb.x += b.x * r * gb.x; xb.y += b.y * r * gb.y; xb.z += b.z * r * gb.z; xb.w += b.w * r * gb.w;
    float4* po = (float4*)(xout + row * DM);
    po[threadIdx.x] = xa; po[threadIdx.x + 256] = xb;
    if (hout) {
        float s2 = xa.x * xa.x + xa.y * xa.y + xa.z * xa.z + xa.w * xa.w + xb.x * xb.x + xb.y * xb.y + xb.z * xb.z + xb.w * xb.w;
        s2 = block_sum_256(s2, red);
        const float r2 = 1.0f / sqrtf(s2 * (1.0f / DM) + EPS);
        const float4 ha = ((const float4*)g2)[threadIdx.x], hb = ((const float4*)g2)[threadIdx.x + 256];
        float4* ph = (float4*)(hout + row * DM);
        ph[threadIdx.x] = make_float4(xa.x * r2 * ha.x, xa.y * r2 * ha.y, xa.z * r2 * ha.z, xa.w * r2 * ha.w);
        ph[threadIdx.x + 256] = make_float4(xb.x * r2 * hb.x, xb.y * r2 * hb.y, xb.z * r2 * hb.z, xb.w * r2 * hb.w);
    }
}

__global__ void __launch_bounds__(256) k_gemm(const float* __restrict__ A, int lda, const float* __restrict__ B, int ldb, float* C, int ldc, int N, int K,
                                               int mode, const float* __restrict__ G, int ldg) {
    __shared__ float As[16][128 + 4];
    __shared__ float Bs[16][128 + 4];
    const int tid = threadIdx.x, tx = tid & 15, ty = tid >> 4;
    const int row0 = blockIdx.y * 128, col0 = blockIdx.x * 128;
    float acc[8][8];
#pragma unroll
    for (int i = 0; i < 8; ++i)
#pragma unroll
        for (int j = 0; j < 8; ++j) acc[i][j] = 0.f;
    for (int k0 = 0; k0 < K; k0 += 16) {
#pragma unroll
        for (int i = 0; i < 2; ++i) {
            const int f = tid + i * 256;
            const int r = f >> 2, kq = (f & 3) * 4;
            const float4 v = *(const float4*)(A + (size_t)(row0 + r) * lda + k0 + kq);
            As[kq + 0][r] = v.x; As[kq + 1][r] = v.y; As[kq + 2][r] = v.z; As[kq + 3][r] = v.w;
            const int kk = f >> 5, c4 = (f & 31) * 4;
            float4 w = make_float4(0.f, 0.f, 0.f, 0.f);
            if (col0 + c4 < N) w = *(const float4*)(B + (size_t)(k0 + kk) * ldb + col0 + c4);
            *(float4*)&Bs[kk][c4] = w;
        }
        __syncthreads();
#pragma unroll
        for (int k = 0; k < 16; ++k) {
            const float4 a0 = *(const float4*)&As[k][ty * 4], a1 = *(const float4*)&As[k][64 + ty * 4];
            const float4 b0 = *(const float4*)&Bs[k][tx * 4], b1 = *(const float4*)&Bs[k][64 + tx * 4];
            const float av[8] = {a0.x, a0.y, a0.z, a0.w, a1.x, a1.y, a1.z, a1.w};
            const float bv[8] = {b0.x, b0.y, b0.z, b0.w, b1.x, b1.y, b1.z, b1.w};
#pragma unroll
            for (int i = 0; i < 8; ++i)
#pragma unroll
                for (int j = 0; j < 8; ++j) acc[i][j] += av[i] * bv[j];
        }
        __syncthreads();
    }
#pragma unroll
    for (int i = 0; i < 8; ++i) {
        const int r = row0 + (i < 4 ? ty * 4 + i : 64 + ty * 4 + (i - 4));
#pragma unroll
        for (int jh = 0; jh < 2; ++jh) {
            const int c = col0 + jh * 64 + tx * 4;
            if (c < N) {
                float4 v = make_float4(acc[i][jh * 4 + 0], acc[i][jh * 4 + 1], acc[i][jh * 4 + 2], acc[i][jh * 4 + 3]);
                float* cp = C + (size_t)r * ldc + c;
                if (mode != 0) {
                    const float4 gl = *(const float4*)(G + (size_t)r * ldg + c);
                    v.x *= 1.0f / (1.0f + expf(-gl.x)); v.y *= 1.0f / (1.0f + expf(-gl.y)); v.z *= 1.0f / (1.0f + expf(-gl.z)); v.w *= 1.0f / (1.0f + expf(-gl.w));
                    if (mode == 2) { const float4 o = *(const float4*)cp; v.x += o.x; v.y += o.y; v.z += o.z; v.w += o.w; }
                }
                *(float4*)cp = v;
            }
        }
    }
}

template <int DPL> struct WaveAttn {
    float m, l, acc[DPL];
    __device__ __forceinline__ void init() { m = -INFINITY; l = 0.f;
#pragma unroll
        for (int i = 0; i < DPL; ++i) acc[i] = 0.f; }
    __device__ __forceinline__ void step(float logit, const float (&v)[DPL]) {
        const float mn = fmaxf(m, logit);
        const float sc = __expf(m - mn), p = __expf(logit - mn);
        l = l * sc + p;
#pragma unroll
        for (int i = 0; i < DPL; ++i) acc[i] = acc[i] * sc + p * v[i];
        m = mn;
    }
};

__global__ void __launch_bounds__(512) k_attn_a(const float* __restrict__ P, const float* __restrict__ relb  , float* __restrict__ cat  ) {
    const int t = blockIdx.x, h = threadIdx.x >> 6, lane = threadIdx.x & 63;
    const int b = t / SEQ, pos = t % SEQ, c = pos / CHUNK;
    const float q = P[(size_t)t * IN_W + O_QA + h * 64 + lane];
    WaveAttn<1> st; st.init();
    const int c_lo = c - A_LEFT < 0 ? 0 : c - A_LEFT;
    for (int kp = c_lo * CHUNK; kp < (c + 1) * CHUNK; ++kp) {
        const size_t kr = (size_t)(b * SEQ + kp) * IN_W;
        const float kv = P[kr + O_KA + h * 64 + lane];
        const float dot = wave_sum(q * kv);
        int rel = pos - kp; rel = rel < -A_MAXREL ? -A_MAXREL : rel > A_MAXREL ? A_MAXREL : rel;
        const float logit = dot * 0.125f + relb[(rel + A_MAXREL) * A_HEADS + h];
        const float vv[1] = {P[kr + O_VA + h * 64 + lane]};
        st.step(logit, vv);
    }
    cat[(size_t)t * DM + h * 64 + lane] = st.acc[0] / st.l;
}

__global__ void __launch_bounds__(1024) k_attn_c(const float* __restrict__ P, const float* __restrict__ t5  , const float* __restrict__ sinks  , float* __restrict__ cat) {
    const int t = blockIdx.x, hq = threadIdx.x >> 6, lane = threadIdx.x & 63;
    const int kvh = hq / 8;
    const int b = t / SEQ, pos = t % SEQ, c = pos / CHUNK;
    const float q = P[(size_t)t * IN_W + O_QC + hq * 64 + lane];
    WaveAttn<1> st; st.init();
    const int c_lo = c - C_LEFT < 0 ? 0 : c - C_LEFT;
    for (int kp = c_lo * CHUNK; kp < (c + 1) * CHUNK; ++kp) {
        const size_t kr = (size_t)(b * SEQ + kp) * IN_W;
        const float kv = P[kr + O_KC + kvh * 64 + lane];
        const float dot = wave_sum(q * kv);
        const float logit = dot * 0.125f + t5[t5_bucket(kp - pos) * NT5 + B_HEADS + hq];
        const float vv[1] = {P[kr + O_VC + kvh * 64 + lane]};
        st.step(logit, vv);
    }
    const float sk = sinks[hq];
    const float mn = fmaxf(st.m, sk);
    const float denom = st.l * __expf(st.m - mn) + __expf(sk - mn);
    cat[(size_t)t * DM + 1024 + hq * 64 + lane] = st.acc[0] * __expf(st.m - mn) / denom;
}

__global__ void __launch_bounds__(256) k_ckvn(const float* __restrict__ P, const float* __restrict__ gain, float* __restrict__ ckvn) {
    const int t = blockIdx.x * 4 + (threadIdx.x >> 6), lane = threadIdx.x & 63;
    const float2 v = *(const float2*)(P + (size_t)t * IN_W + O_CKV + 2 * lane);
    const float ss = wave_sum(v.x * v.x + v.y * v.y);
    const float r = 1.0f / sqrtf(ss * (1.0f / B_LAT) + EPS);
    *(float2*)(ckvn + (size_t)t * B_LAT + 2 * lane) = make_float2(v.x * r * gain[2 * lane], v.y * r * gain[2 * lane + 1]);
}
__global__ void __launch_bounds__(256) k_idx_score(const float* __restrict__ P, float* __restrict__ score  ) {
    __shared__ float qis[IDX_HEADS * IDX_DIM];
    __shared__ float wis[IDX_HEADS];
    const int t = blockIdx.x, b = t / SEQ, pos = t % SEQ, n = (pos / CHUNK + 1) * CHUNK;
    for (int i = threadIdx.x; i < IDX_HEADS * IDX_DIM; i += 256) qis[i] = P[(size_t)t * IN_W + O_QI + i];
    if (threadIdx.x < IDX_HEADS) wis[threadIdx.x] = P[(size_t)t * IN_W + O_WI + threadIdx.x] * 0.35355339059327373f;
    __syncthreads();
    for (int s = threadIdx.x; s < n; s += 256) {
        const float* kr = P + (size_t)(b * SEQ + s) * IN_W + O_KI;
        float a0 = 0.f, a1 = 0.f, a2 = 0.f, a3 = 0.f, a4 = 0.f, a5 = 0.f, a6 = 0.f, a7 = 0.f;
        for (int d = 0; d < IDX_DIM; ++d) {
            const float kv = kr[d];
            a0 += qis[0 * 64 + d] * kv; a1 += qis[1 * 64 + d] * kv; a2 += qis[2 * 64 + d] * kv; a3 += qis[3 * 64 + d] * kv;
            a4 += qis[4 * 64 + d] * kv; a5 += qis[5 * 64 + d] * kv; a6 += qis[6 * 64 + d] * kv; a7 += qis[7 * 64 + d] * kv;
        }
        float sc = fmaxf(a0 * 0.125f, 0.f) * wis[0];
        sc += fmaxf(a1 * 0.125f, 0.f) * wis[1]; sc += fmaxf(a2 * 0.125f, 0.f) * wis[2]; sc += fmaxf(a3 * 0.125f, 0.f) * wis[3];
        sc += fmaxf(a4 * 0.125f, 0.f) * wis[4]; sc += fmaxf(a5 * 0.125f, 0.f) * wis[5]; sc += fmaxf(a6 * 0.125f, 0.f) * wis[6]; sc += fmaxf(a7 * 0.125f, 0.f) * wis[7];
        score[(size_t)t * SEQ + s] = sc;
    }
}
__global__ void __launch_bounds__(256) k_select(const float* __restrict__ score, unsigned char* __restrict__ sel) {
    __shared__ unsigned keys[SEQ];
    __shared__ int cnt;
    __shared__ int eqoff[257];
    const int t = blockIdx.x, pos = t % SEQ, n = (pos / CHUNK + 1) * CHUNK, tid = threadIdx.x;
    unsigned char* so = sel + (size_t)t * SEQ;
    if (n <= TOPK) { for (int i = tid; i < n; i += 256) so[i] = 1; return; }
    for (int i = tid; i < n; i += 256) {
        const float f = score[(size_t)t * SEQ + i] + 0.0f;
        const unsigned u = __float_as_uint(f);
        keys[i] = (u & 0x80000000u) ? ~u : (u | 0x80000000u);
    }
    __syncthreads();
    unsigned T = 0u;
    for (int bit = 31; bit >= 0; --bit) {
        const unsigned cand = T | (1u << bit);
        if (tid == 0) cnt = 0;
        __syncthreads();
        int c = 0;
        for (int i = tid; i < n; i += 256) c += keys[i] >= cand ? 1 : 0;
        c = (int)wave_sum((float)c);
        if ((tid & 63) == 0) atomicAdd(&cnt, c);
        __syncthreads();
        if (cnt >= TOPK) T = cand;
        __syncthreads();
    }
    int gt = 0, eq = 0;
    for (int i = tid * 8; i < tid * 8 + 8; ++i) if (i < n) { gt += keys[i] > T ? 1 : 0; eq += keys[i] == T ? 1 : 0; }
    if (tid == 0) cnt = 0;
    __syncthreads();
    eqoff[tid + 1] = eq;
    { int g = (int)wave_sum((float)gt); if ((tid & 63) == 0) atomicAdd(&cnt, g); }
    __syncthreads();
    if (tid == 0) { eqoff[0] = 0; for (int i = 1; i <= 256; ++i) eqoff[i] += eqoff[i - 1]; }
    __syncthreads();
    const int need = TOPK - cnt;
    int er = eqoff[tid];
    for (int i = tid * 8; i < tid * 8 + 8; ++i) if (i < n) {
        unsigned char v = 0;
        if (keys[i] > T) v = 1; else if (keys[i] == T) { v = er < need ? 1 : 0; ++er; }
        so[i] = v;
    }
}
__global__ void __launch_bounds__(512) k_attn_b(const float* __restrict__ P, const float* __restrict__ ckvn, const unsigned char* __restrict__ sel, const float* __restrict__ wuk  ,
                                                 const float* __restrict__ wuv  , const float* __restrict__ t5, float* __restrict__ cat) {
    __shared__ float qs[B_HEADS][64];
    __shared__ float ol[B_HEADS][B_LAT];
    const int t = blockIdx.x, h = threadIdx.x >> 6, lane = threadIdx.x & 63;
    const int b = t / SEQ, pos = t % SEQ, n = (pos / CHUNK + 1) * CHUNK;
    qs[h][lane] = P[(size_t)t * IN_W + O_QB + h * 64 + lane];
    __syncthreads();
    float ql[2] = {0.f, 0.f};
    {
        const float* w0 = wuk + ((size_t)h * B_LAT + 2 * lane) * 64;
        for (int d = 0; d < 64; ++d) { ql[0] += qs[h][d] * w0[d]; ql[1] += qs[h][d] * w0[64 + d]; }
    }
    WaveAttn<2> st; st.init();
    const unsigned char* sp = sel + (size_t)t * SEQ;
    for (int s = 0; s < n; ++s) {
        if (!sp[s]) continue;
        const float2 cv = *(const float2*)(ckvn + (size_t)(b * SEQ + s) * B_LAT + 2 * lane);
        const float dot = wave_sum(ql[0] * cv.x + ql[1] * cv.y);
        const float logit = dot * 0.125f + t5[t5_bucket(s - pos) * NT5 + h];
        const float vv[2] = {cv.x, cv.y};
        st.step(logit, vv);
    }
    ol[h][2 * lane] = st.acc[0] / st.l; ol[h][2 * lane + 1] = st.acc[1] / st.l;
    __syncthreads();
    float o = 0.f;
    const float* wv = wuv + (size_t)h * B_LAT * 64 + lane;
    for (int c = 0; c < B_LAT; ++c) o += ol[h][c] * wv[(size_t)c * 64];
    cat[(size_t)t * DM + 512 + h * 64 + lane] = o;
}

__global__ void __launch_bounds__(256) k_attn_mem(const float* __restrict__ qm, const float* __restrict__ kvm, float* __restrict__ om) {
    const int t = blockIdx.x, h = threadIdx.x >> 6, lane = threadIdx.x & 63;
    const int b = t / SEQ;
    const float2 q = *(const float2*)(qm + (size_t)t * MEM_W + h * MEM_HD + 2 * lane);
    WaveAttn<2> st; st.init();
    for (int m = 0; m < MEM_LEN; ++m) {
        const float* kr = kvm + (size_t)(b * MEM_LEN + m) * (2 * MEM_W);
        const float2 kv = *(const float2*)(kr + h * MEM_HD + 2 * lane);
        const float dot = wave_sum(q.x * kv.x + q.y * kv.y);
        const float2 v2 = *(const float2*)(kr + MEM_W + h * MEM_HD + 2 * lane);
        const float vv[2] = {v2.x, v2.y};
        st.step(dot * 0.08838834764831845f, vv);
    }
    *(float2*)(om + (size_t)t * MEM_W + h * MEM_HD + 2 * lane) = make_float2(st.acc[0] / st.l, st.acc[1] / st.l);
}

__device__ __forceinline__ float gelu_tanh(float x) { const float k = 0.7978845608028654f; return 0.5f * x * (1.0f + tanhf(k * (x + 0.044715f * x * x * x))); }
__global__ void __launch_bounds__(256) k_conv_act(const float* __restrict__ u, const float* __restrict__ cw  , const float* __restrict__ cb  , float* __restrict__ act  ) {
    const int r = blockIdx.x, pos = r % SEQ;
    for (int c = threadIdx.x; c < DFF; c += 256) {
        float g = cb[c], v = cb[DFF + c];
#pragma unroll
        for (int j = 0; j < 3; ++j) {
            const int sp = pos - 2 + j;
            if (sp >= 0) { const float* ur = u + (size_t)(r - 2 + j) * (2 * DFF); g += ur[c] * cw[j * 2 * DFF + c]; v += ur[DFF + c] * cw[j * 2 * DFF + DFF + c]; }
        }
        act[(size_t)r * DFF + c] = gelu_tanh(g) * v;
    }
}

static void gemm(hipStream_t st, const float* A, int lda, const float* B, int ldb, float* C, int ldc, int M, int N, int K, int mode = 0, const float* G = nullptr, int ldg = 0) {
    dim3 grid((N + 127) / 128, M / 128);
    hipLaunchKernelGGL(k_gemm, grid, dim3(256), 0, st, A, lda, B, ldb, C, ldc, N, K, mode, G, ldg);
}

extern "C" void kernel_launch(void* const* d_in, const int* in_sizes, int n_in, void* d_out, int out_size, void* d_ws, size_t ws_size, hipStream_t stream) {
    const float* x_in = (const float*)d_in[0];
    const float* mem = (const float*)d_in[1];
    const float* t5 = (const float*)d_in[2];
    const float* gains = (const float*)d_in[3];
    const float* w_in = (const float*)d_in[4];
    const float* a_rel = (const float*)d_in[5];
    const float* ckv_gain = (const float*)d_in[6];
    const float* w_uk = (const float*)d_in[7];
    const float* w_uv = (const float*)d_in[8];
    const float* sinks = (const float*)d_in[9];
    const float* w_branch = (const float*)d_in[10];
    const float* w_o = (const float*)d_in[11];
    const float* mem_gain = (const float*)d_in[12];
    const float* w_mq = (const float*)d_in[13];
    const float* w_mkv = (const float*)d_in[14];
    const float* w_mo = (const float*)d_in[15];
    const float* w_up = (const float*)d_in[16];
    const float* conv_w = (const float*)d_in[17];
    const float* conv_b = (const float*)d_in[18];
    const float* w_down = (const float*)d_in[19];
    float* out = (float*)d_out;

    const size_t XSZ = (size_t)MROWS * DM;
    float* ws = (float*)d_ws;
    float* hy = ws;
    float* big = hy + XSZ;
    const size_t BIGSZ = (size_t)MROWS * IN_W;
    float* cat = big + BIGSZ;
    float* mrg = cat + XSZ;
    const size_t need = (XSZ * 3 + BIGSZ) * sizeof(float) + (size_t)MROWS * SEQ + (size_t)MROWS * B_LAT * 4;
    float* ckvn = mrg + XSZ;
    unsigned char* sel = (unsigned char*)(ckvn + (size_t)MROWS * B_LAT);
    if (ws_size < need) { fprintf(stderr, "kernel_launch: workspace too small: %zu < %zu\n", ws_size, need); return; }
    float* xc = out;

    for (int l = 0; l < DEPTH; ++l) {
        const float* g = gains + (size_t)l * 6 * DM;
        if (l == 0) hipLaunchKernelGGL(k_rmsnorm, dim3(MROWS), dim3(256), 0, stream, x_in, g, hy);
        float* P = big;
        gemm(stream, hy, DM, w_in + (size_t)l * DM * IN_W, IN_W, P, IN_W, MROWS, IN_W, DM);
        hipLaunchKernelGGL(k_attn_a, dim3(MROWS), dim3(512), 0, stream, P, a_rel + (size_t)l * 257 * A_HEADS, cat);
        hipLaunchKernelGGL(k_attn_c, dim3(MROWS), dim3(1024), 0, stream, P, t5, sinks + (size_t)l * C_QH, cat);
        hipLaunchKernelGGL(k_ckvn, dim3(MROWS / 4), dim3(256), 0, stream, P, ckv_gain + (size_t)l * B_LAT, ckvn);
        hipLaunchKernelGGL(k_idx_score, dim3(MROWS), dim3(256), 0, stream, P, mrg);
        hipLaunchKernelGGL(k_select, dim3(MROWS), dim3(256), 0, stream, mrg, sel);
        hipLaunchKernelGGL(k_attn_b, dim3(MROWS), dim3(512), 0, stream, P, ckvn, sel, w_uk + (size_t)l * B_HEADS * B_LAT * 64, w_uv + (size_t)l * B_HEADS * B_LAT * 64, t5, cat);
        const float* wb = w_branch + (size_t)l * DM * DM;
        gemm(stream, cat, DM, wb, DM, mrg, DM, MROWS, DM, 512, 1, P + O_GL, IN_W);
        gemm(stream, cat + 512, DM, wb + (size_t)512 * DM, DM, mrg, DM, MROWS, DM, 512, 2, P + O_GL + DM, IN_W);
        gemm(stream, cat + 1024, DM, wb + (size_t)1024 * DM, DM, mrg, DM, MROWS, DM, 1024, 2, P + O_GL + 2 * DM, IN_W);
        gemm(stream, mrg, DM, w_o + (size_t)l * DM * DM, DM, hy, DM, MROWS, DM, DM);
        hipLaunchKernelGGL(k_resnorm, dim3(MROWS), dim3(256), 0, stream, l == 0 ? x_in : xc, hy, g + DM, xc, g + 2 * DM, hy);
        float* memn = mrg;
        float* kvm = memn + (size_t)NBATCH * MEM_LEN * DM;
        float* qm = kvm + (size_t)NBATCH * MEM_LEN * 2 * MEM_W;
        float* om = qm + (size_t)MROWS * MEM_W;
        hipLaunchKernelGGL(k_rmsnorm, dim3(NBATCH * MEM_LEN), dim3(256), 0, stream, mem, mem_gain + (size_t)l * DM, memn);
        gemm(stream, memn, DM, w_mkv + (size_t)l * DM * 2 * MEM_W, 2 * MEM_W, kvm, 2 * MEM_W, NBATCH * MEM_LEN, 2 * MEM_W, DM);
        gemm(stream, hy, DM, w_mq + (size_t)l * DM * MEM_W, MEM_W, qm, MEM_W, MROWS, MEM_W, DM);
        hipLaunchKernelGGL(k_attn_mem, dim3(MROWS), dim3(256), 0, stream, qm, kvm, om);
        gemm(stream, om, MEM_W, w_mo + (size_t)l * MEM_W * DM, DM, hy, DM, MROWS, DM, MEM_W);
        hipLaunchKernelGGL(k_resnorm, dim3(MROWS), dim3(256), 0, stream, xc, hy, g + 3 * DM, xc, g + 4 * DM, hy);
        float* u = big;
        float* act = u + (size_t)4096 * 2 * DFF;
        float* y = cat;
        for (int hf = 0; hf < 2; ++hf) {
            gemm(stream, hy + (size_t)hf * 4096 * DM, DM, w_up + (size_t)l * DM * 2 * DFF, 2 * DFF, u, 2 * DFF, 4096, 2 * DFF, DM);
            hipLaunchKernelGGL(k_conv_act, dim3(4096), dim3(256), 0, stream, u, conv_w + (size_t)l * 3 * 2 * DFF, conv_b + (size_t)l * 2 * DFF, act);
            gemm(stream, act, DFF, w_down + (size_t)l * DFF * DM, DM, y + (size_t)hf * 4096 * DM, DM, 4096, DM, DFF);
        }
        const float* gn = (l + 1 < DEPTH) ? gains + (size_t)(l + 1) * 6 * DM : nullptr;
        hipLaunchKernelGGL(k_resnorm, dim3(MROWS), dim3(256), 0, stream, xc, y, g + 5 * DM, xc, gn, gn ? hy : nullptr);
    }
}
```

```cpp
#include <hip/hip_runtime.h>
#include <hip/hip_bf16.h>
#include <cstdio>
#include <cstdint>
#include <cmath>

#define GAS __attribute__((address_space(1)))
#define LAS __attribute__((address_space(3)))
typedef unsigned short bf16_t;
typedef short bf16x8 __attribute__((ext_vector_type(8)));
typedef short s16x4 __attribute__((ext_vector_type(4)));
typedef float f32x2 __attribute__((ext_vector_type(2)));
typedef float f32x4 __attribute__((ext_vector_type(4)));
typedef float f32x16 __attribute__((ext_vector_type(16)));
typedef unsigned u32x2 __attribute__((ext_vector_type(2)));
typedef unsigned u32x4 __attribute__((ext_vector_type(4)));

namespace pg8 {
constexpr int BM = 256, BK = 64, HALF = 128, HTB = HALF * BK * 2  , STAGE_BYTES = 8 * HTB, NXCD = 8, WGM = 8;
constexpr int TAG_KEEP = 0x100;

__host__ __device__ __forceinline__ int lds_byte(int r, int c) { const int st = (r >> 4) * 2 + (c >> 5), rr = r & 15, cc = c & 31, ob = rr * 64 + cc * 2; return st * 1024 + (ob ^ (((ob >> 9) & 1) << 5)); }
__host__ __device__ __forceinline__ void stage_rc(int b, int& R, int& C) { const int st = b / 1024, sb = b % 1024, swz = sb ^ (((sb >> 9) & 1) << 5); R = (st >> 1) * 16 + swz / 64; C = (st & 1) * 32 + (swz % 64) / 2; }
__host__ __device__ __forceinline__ int perm32(int rho) { const int n = rho >> 4, i = rho & 15; return 8 * (i >> 2) + 4 * n + (i & 3); }

struct Unit { int pm, pn, nt, tag; const char* A; const char* B; };

__device__ __forceinline__ bool tile_order(int nM, int nN, int G, int c, int i, int& pm, int& pn) {
    const int nwg = nM * nN; const long L = (long)i * G + c; if (L >= nwg) return false;
    int wgid = (int)L; { const int q = nwg / NXCD, r = nwg % NXCD, xcd = wgid % NXCD, off = wgid / NXCD; wgid = (xcd < r ? xcd * (q + 1) : r * (q + 1) + (xcd - r) * q) + off; }
    const int nig = WGM * nN, gid = wgid / nig, fm = gid * WGM, gsz = (nM - fm) < WGM ? (nM - fm) : WGM;
    pm = fm + ((wgid % nig) % gsz); pn = (wgid % nig) / gsz; return true;
}
struct SchedGrid {
    const bf16_t* A; const bf16_t* Bt; int nM, nN, K, G, c;
    __device__ __forceinline__ bool next(int i, Unit& u) const {
        if (!tile_order(nM, nN, G, c, i, u.pm, u.pn)) return false;
        u.nt = K / BK; u.tag = 0; u.A = (const char*)(A + (size_t)u.pm * BM * K); u.B = (const char*)(Bt + (size_t)u.pn * BM * K); return true;
    }
};

__device__ __forceinline__ unsigned cvt_pk_bf16(float lo, float hi) { unsigned r; asm volatile("v_cvt_pk_bf16_f32 %0, %1, %2" : "=v"(r) : "v"(lo), "v"(hi)); return r; }
__device__ __forceinline__ float bf_lo(unsigned w) { return __uint_as_float(w << 16); }
__device__ __forceinline__ float bf_hi(unsigned w) { return __uint_as_float(w & 0xffff0000u); }
__device__ __forceinline__ float sigmoidf_fast(float v) { return __builtin_amdgcn_rcpf(1.0f + __builtin_amdgcn_exp2f(-1.4426950408889634f * v)); }

struct EpiStore {
    static constexpr bool PERM = true;
    bf16_t* O; int ldc; int sig_pn0; bf16_t* O2; int ldc2;
    __device__ __forceinline__ void operator()(f32x4 (&acc)[2][2][4][2], const Unit& u, int wr, int wc, int fr, int fq) const {
        const int row0 = u.pm * BM + wr * 64 + fr, col0 = u.pn * BM + wc * 32 + 8 * fq;
        bf16_t* base = (u.tag & 1) ? O2 : O; const int ld = (u.tag & 1) ? ldc2 : ldc;
        const bool sg = u.pn >= sig_pn0;
#pragma unroll
        for (int ai = 0; ai < 2; ++ai)
#pragma unroll
            for (int m = 0; m < 4; ++m) { bf16_t* rowp = base + (size_t)(row0 + ai * HALF + m * 16) * ld + col0;
#pragma unroll
                for (int bj = 0; bj < 2; ++bj) { f32x4 v0 = acc[ai][bj][m][0], v1 = acc[ai][bj][m][1];
                    if (sg) { v0[0] = sigmoidf_fast(v0[0]); v0[1] = sigmoidf_fast(v0[1]); v0[2] = sigmoidf_fast(v0[2]); v0[3] = sigmoidf_fast(v0[3]);
                              v1[0] = sigmoidf_fast(v1[0]); v1[1] = sigmoidf_fast(v1[1]); v1[2] = sigmoidf_fast(v1[2]); v1[3] = sigmoidf_fast(v1[3]); }
                    u32x4 w; w.x = cvt_pk_bf16(v0[0], v0[1]); w.y = cvt_pk_bf16(v0[2], v0[3]); w.z = cvt_pk_bf16(v1[0], v1[1]); w.w = cvt_pk_bf16(v1[2], v1[3]);
                    *(u32x4*)(rowp + bj * HALF) = w; } }
    }
};
struct EpiBranch {
    static constexpr bool PERM = true;
    const bf16_t* G; int ldg; bf16_t* O; int ldc;
    __device__ __forceinline__ void operator()(f32x4 (&acc)[2][2][4][2], const Unit& u, int wr, int wc, int fr, int fq) const {
        const int seg = u.tag & 3;
        const int row0 = u.pm * BM + wr * 64 + fr, col0 = u.pn * BM + wc * 32 + 8 * fq;
#pragma unroll
        for (int ai = 0; ai < 2; ++ai)
#pragma unroll
            for (int m = 0; m < 4; ++m) { const size_t r = (size_t)(row0 + ai * HALF + m * 16);
#pragma unroll
                for (int bj = 0; bj < 2; ++bj) {
                    const bf16_t* gp = G + r * ldg + col0 + bj * HALF + (seg == 2 ? 4096 : seg == 1 ? 2048 : 0);
                    const u32x4 ga = *(const u32x4*)gp;
                    float f[8];
                    if (seg == 2) { f[0] = bf_lo(ga.x); f[1] = bf_hi(ga.x); f[2] = bf_lo(ga.y); f[3] = bf_hi(ga.y); f[4] = bf_lo(ga.z); f[5] = bf_hi(ga.z); f[6] = bf_lo(ga.w); f[7] = bf_hi(ga.w); }
                    else { const u32x4 gb = *(const u32x4*)(gp + 2048);
                        f[0] = bf_lo(ga.x) * __builtin_amdgcn_rcpf(bf_lo(gb.x)); f[1] = bf_hi(ga.x) * __builtin_amdgcn_rcpf(bf_hi(gb.x));
                        f[2] = bf_lo(ga.y) * __builtin_amdgcn_rcpf(bf_lo(gb.y)); f[3] = bf_hi(ga.y) * __builtin_amdgcn_rcpf(bf_hi(gb.y));
                        f[4] = bf_lo(ga.z) * __builtin_amdgcn_rcpf(bf_lo(gb.z)); f[5] = bf_hi(ga.z) * __builtin_amdgcn_rcpf(bf_hi(gb.z));
                        f[6] = bf_lo(ga.w) * __builtin_amdgcn_rcpf(bf_lo(gb.w)); f[7] = bf_hi(ga.w) * __builtin_amdgcn_rcpf(bf_hi(gb.w)); }
                    f32x4 v0 = acc[ai][bj][m][0], v1 = acc[ai][bj][m][1];
                    v0[0] *= f[0]; v0[1] *= f[1]; v0[2] *= f[2]; v0[3] *= f[3]; v1[0] *= f[4]; v1[1] *= f[5]; v1[2] *= f[6]; v1[3] *= f[7];
                    if (seg == 2) { u32x4 w; w.x = cvt_pk_bf16(v0[0], v0[1]); w.y = cvt_pk_bf16(v0[2], v0[3]); w.z = cvt_pk_bf16(v1[0], v1[1]); w.w = cvt_pk_bf16(v1[2], v1[3]);
                        *(u32x4*)(O + r * ldc + col0 + bj * HALF) = w; }
                    else { acc[ai][bj][m][0] = v0; acc[ai][bj][m][1] = v1; } } }
    }
};

template <class Epi, class Sched>
__device__ __forceinline__ void gemm_phase(LAS unsigned char* lds, const int ldk, const Sched& S, const Epi& E, const int wid  , const int lane  ) {
    const int tid = wid * 64 + lane, wr = wid >> 2, wc = wid & 3, fr = lane & 15, fq = lane >> 4;
    unsigned voffA[2], voffB[2];
#pragma unroll
    for (int i = 0; i < 2; ++i) { int R, C; stage_rc(tid * 16 + i * 8192, R, C); const int Rb = Epi::PERM ? ((R & ~31) + perm32(R & 31)) : R;
        voffA[i] = (unsigned)(R * ldk + C) * 2u; voffB[i] = (unsigned)(Rb * ldk + C) * 2u; }
    const size_t kstep = (size_t)(BK * 2);
    const size_t hstep = (size_t)HALF * ldk * 2;
    const unsigned ldsw = (unsigned)wid * 1024u;
    const int aoff = lds_byte(wr * 64 + fr, fq * 8), boff = lds_byte(wc * 32 + fr, fq * 8);
#define PG8_SA(b, h) (((b) * 2 + (h)) * HTB)
#define PG8_SB(b, h) ((4 + (b) * 2 + (h)) * HTB)
#define PG8_STAGE(bufoff, gbase, voff) do { _Pragma("unroll") for (int _i = 0; _i < 2; ++_i) \
        __builtin_amdgcn_global_load_lds((const unsigned*)((const char*)(gbase) + (voff)[_i]), (LAS unsigned*)(lds + (bufoff) + ldsw + _i * 8192), 16, 0, 0); } while (0)
#define PG8_LDA(dst, b, h) do { _Pragma("unroll") for (int m = 0; m < 4; ++m) _Pragma("unroll") for (int k = 0; k < 2; ++k) dst[m][k] = *(const LAS bf16x8*)(lds + PG8_SA(b, h) + aoff + m * 2048 + k * 1024); } while (0)
#define PG8_LDB(dst, b, h) do { _Pragma("unroll") for (int n = 0; n < 2; ++n) _Pragma("unroll") for (int k = 0; k < 2; ++k) dst[n][k] = *(const LAS bf16x8*)(lds + PG8_SB(b, h) + boff + n * 2048 + k * 1024); } while (0)
#define PG8_MMA(ai, bj, At, Bt) do { __builtin_amdgcn_s_setprio(1); _Pragma("unroll") for (int m = 0; m < 4; ++m) _Pragma("unroll") for (int n = 0; n < 2; ++n) _Pragma("unroll") for (int k = 0; k < 2; ++k) \
        acc[ai][bj][m][n] = __builtin_amdgcn_mfma_f32_16x16x32_bf16(Bt[n][k], At[m][k], acc[ai][bj][m][n], 0, 0, 0); __builtin_amdgcn_s_setprio(0); } while (0)
#define PG8_WAIT_V(n) asm volatile("s_waitcnt vmcnt(" #n ")" ::: "memory")
#define PG8_WAIT_L(n) asm volatile("s_waitcnt lgkmcnt(" #n ")" ::: "memory")
#define PG8_BAR __builtin_amdgcn_s_barrier()
#define PG8_SCHED __builtin_amdgcn_sched_barrier(0)
    Unit cur, nxt; int ui = 0;
    if (!S.next(0, cur)) return;
    f32x4 acc[2][2][4][2];
#pragma unroll
    for (int a = 0; a < 2; ++a)
#pragma unroll
        for (int b = 0; b < 2; ++b)
#pragma unroll
            for (int m = 0; m < 4; ++m)
#pragma unroll
                for (int n = 0; n < 2; ++n) acc[a][b][m][n] = (f32x4){0.f, 0.f, 0.f, 0.f};
    bf16x8 At[4][2], B0[2][2], B1[2][2];
    const char* cA = cur.A; const char* cB = cur.B;
    PG8_STAGE(PG8_SB(0, 0), cB, voffB); PG8_STAGE(PG8_SB(0, 1), cB + hstep, voffB); PG8_STAGE(PG8_SA(0, 0), cA, voffA); PG8_STAGE(PG8_SA(0, 1), cA + hstep, voffA);
    if (wr == 1) PG8_BAR;
    PG8_WAIT_V(2); PG8_BAR;
    PG8_STAGE(PG8_SB(1, 0), cB + kstep, voffB); PG8_STAGE(PG8_SA(1, 0), cA + kstep, voffA); PG8_STAGE(PG8_SB(1, 1), cB + hstep + kstep, voffB);
    PG8_WAIT_V(6); PG8_BAR;
    for (;;) {
        const bool has_next = S.next(ui + 1, nxt);
        const char* nA = has_next ? nxt.A : cA; const char* nB = has_next ? nxt.B : cB;
        const int nt = cur.nt;
        for (int t = 0; t < nt; t += 2) {
            const bool last = (t == nt - 2);
            const char* a1 = cA + (size_t)(t + 1) * kstep;
            const char* a2 = last ? nA : cA + (size_t)(t + 2) * kstep; const char* b2 = last ? nB : cB + (size_t)(t + 2) * kstep;
            const char* a3 = a2 + kstep; const char* b3 = b2 + kstep;
            PG8_LDB(B0, 0, 0); PG8_LDB(B1, 0, 1); PG8_SCHED; PG8_LDA(At, 0, 0); PG8_STAGE(PG8_SA(1, 1), a1 + hstep, voffA);
            PG8_WAIT_V(8); PG8_WAIT_L(0); PG8_BAR; PG8_MMA(0, 0, At, B0); PG8_MMA(0, 1, At, B1); PG8_BAR; PG8_SCHED;
            PG8_LDA(At, 0, 1); PG8_STAGE(PG8_SB(0, 0), b2, voffB); PG8_STAGE(PG8_SB(0, 1), b2 + hstep, voffB); PG8_STAGE(PG8_SA(0, 0), a2, voffA);
            PG8_WAIT_V(8); PG8_WAIT_L(0); PG8_BAR; PG8_MMA(1, 0, At, B0); PG8_MMA(1, 1, At, B1); PG8_BAR; PG8_SCHED;
            PG8_LDB(B0, 1, 0); PG8_LDB(B1, 1, 1); PG8_SCHED; PG8_LDA(At, 1, 0); PG8_STAGE(PG8_SA(0, 1), a2 + hstep, voffA);
            PG8_WAIT_V(8); PG8_WAIT_L(0); PG8_BAR; PG8_MMA(0, 0, At, B0); PG8_MMA(0, 1, At, B1); PG8_BAR; PG8_SCHED;
            PG8_LDA(At, 1, 1); PG8_STAGE(PG8_SB(1, 0), b3, voffB); PG8_STAGE(PG8_SB(1, 1), b3 + hstep, voffB); PG8_STAGE(PG8_SA(1, 0), a3, voffA);
            PG8_WAIT_V(8); PG8_WAIT_L(0); PG8_BAR; PG8_MMA(1, 0, At, B0); PG8_MMA(1, 1, At, B1); PG8_BAR; PG8_SCHED;
        }
        if (wr == 0) PG8_BAR;
        E(acc, cur, wr, wc, fr, fq);
        if (!has_next) break;
        if (!(cur.tag & TAG_KEEP)) {
#pragma unroll
            for (int a = 0; a < 2; ++a)
#pragma unroll
                for (int b = 0; b < 2; ++b)
#pragma unroll
                    for (int m = 0; m < 4; ++m)
#pragma unroll
                        for (int n = 0; n < 2; ++n) acc[a][b][m][n] = (f32x4){0.f, 0.f, 0.f, 0.f};
        }
        cur = nxt; cA = nA; cB = nB; ++ui;
        if (wr == 1) PG8_BAR;
    }
    PG8_WAIT_V(0);
    PG8_BAR;
#undef PG8_SA
#undef PG8_SB
#undef PG8_STAGE
#undef PG8_LDA
#undef PG8_LDB
#undef PG8_MMA
#undef PG8_WAIT_V
#undef PG8_WAIT_L
#undef PG8_BAR
#undef PG8_SCHED
}
}

constexpr int DM = 2048, NBATCH = 4, SEQ = 2048, MROWS = NBATCH * SEQ, DEPTH = 2;
constexpr int CHUNK = 64;
constexpr float EPS = 1e-6f;
constexpr float LOG2E = 1.4426950408889634f;
constexpr int A_HEADS = 8, A_LEFT = 8, A_MAXREL = 128;
constexpr int B_HEADS = 8, B_LAT = 128, IDX_HEADS = 8, IDX_DIM = 64, TOPK = 256;
constexpr int C_QH = 16, C_LEFT = 2;
constexpr int MEM_LEN = 256, MEM_HEADS = 4, MEM_HD = 128, MEM_W = 512;
constexpr int DFF = 5504;
constexpr int IN_W = 10184;
constexpr int LDP = 10240;
constexpr int O_QA = 0, O_KA = 512, O_VA = 1024, O_QB = 1536, O_CKV = 2048, O_QI = 2176, O_KI = 2688, O_WI = 2752, O_QC = 2760, O_KC = 3784, O_VC = 3912, O_GLREAL = 4040, O_GL = 4096;
constexpr int NT5 = 24;
constexpr int NWAVES = 8;

constexpr size_t al256(size_t x) { return (x + 255) & ~(size_t)255; }
constexpr size_t WS_CTL = 0, CTL_ZERO_BYTES = 1u << 20;
constexpr size_t WS_WUK = CTL_ZERO_BYTES;
constexpr size_t WS_WUVT = WS_WUK + (size_t)DEPTH * 8 * 128 * 64 * 2;
constexpr size_t WS_MEMN = WS_WUVT + (size_t)DEPTH * 8 * 128 * 64 * 2;
constexpr size_t WS_KVM = WS_MEMN + (size_t)DEPTH * 1024 * DM * 2;
constexpr size_t WS_CKVN = WS_KVM + (size_t)DEPTH * 1024 * 1024 * 2;
constexpr size_t WS_MASK = WS_CKVN + (size_t)MROWS * B_LAT * 2;
constexpr size_t WS_W0 = WS_MASK + (size_t)MROWS * 64 * 4;
constexpr size_t WL_IN = 0;
constexpr size_t WL_BR = WL_IN + (size_t)LDP * DM * 2;
constexpr size_t WL_O = WL_BR + (size_t)DM * DM * 2;
constexpr size_t WL_MQ = WL_O + (size_t)DM * DM * 2;
constexpr size_t WL_MKV = WL_MQ + (size_t)MEM_W * DM * 2;
constexpr size_t WL_MO = WL_MKV + (size_t)2 * MEM_W * DM * 2;
constexpr size_t WL_UP = WL_MO + (size_t)DM * MEM_W * 2;
constexpr size_t WL_DN = WL_UP + (size_t)2 * DFF * DM * 2;
constexpr size_t WL_SIZE = WL_DN + (size_t)DM * DFF * 2;
constexpr size_t WS_H = WS_W0 + DEPTH * WL_SIZE;
constexpr size_t WS_BIG = WS_H + (size_t)MROWS * DM * 2;
constexpr size_t WS_CAT = WS_BIG + (size_t)MROWS * 2 * DFF * 2;
constexpr size_t WS_MRG = WS_CAT + (size_t)MROWS * DM * 2;
constexpr size_t WS_Y = WS_MRG + (size_t)MROWS * DM * 2;
constexpr size_t WS_ACT = WS_Y + (size_t)MROWS * DM * 2;
constexpr size_t WS_END = WS_ACT + (size_t)MROWS * DFF * 2;
static_assert(WS_W0 % 256 == 0 && WL_SIZE % 256 == 0 && WS_H % 256 == 0 && WS_ACT % 256 == 0, "alignment");
constexpr int CW_BAR = 4096;

constexpr int RING_BYTES = 131072;
constexpr int LDSCTL_OFF = RING_BYTES, MISC_OFF = LDSCTL_OFF + 320;
constexpr int LDS_BYTES = 147456;
constexpr int WAVE_LDS = 16384;

#define XB_TMO      128
#define XB_XCNT(j)  (256  + 64 * (j))
#define XB_XSUB(j)  (1280 + 64 * (j))
#define XB_XGEN(j)  (2304 + 64 * (j))
#define XB_TOP      3328
#define XB_TOPGEN   3392
#define XCD_BAR_WORDS 3456
#define XB_SPIN_CAP (1u << 18)
__device__ __forceinline__ unsigned xb_ld(unsigned* p)              { return __hip_atomic_load(p, __ATOMIC_RELAXED, __HIP_MEMORY_SCOPE_AGENT); }
__device__ __forceinline__ unsigned xb_add(unsigned* p, unsigned v) { return __hip_atomic_fetch_add(p, v, __ATOMIC_RELAXED, __HIP_MEMORY_SCOPE_AGENT); }
__device__ __forceinline__ unsigned xb_xcc_id() { return (unsigned)__builtin_amdgcn_s_getreg((3 << 11) | 20) & 0xFu; }
#define XB_SPIN(cond, bar) do { unsigned _sp = 0; while (cond) { __builtin_amdgcn_s_sleep(1); \
    if ((++_sp & 255u) == 0u) { if (xb_ld(&(bar)[XB_TMO])) break; if (_sp > XB_SPIN_CAP) { atomicAdd(&(bar)[XB_TMO], 1u); break; } } } } while (0)
struct XcdBarrier { unsigned* bar; unsigned x; volatile LAS unsigned* st; };
__device__ __forceinline__ XcdBarrier xcd_barrier_post(unsigned* bar, volatile LAS unsigned* st) {
    XcdBarrier b; b.bar = bar; b.x = xb_xcc_id(); b.st = st;
    if (threadIdx.x == 0) (void)xb_add(&bar[XB_XCNT(b.x)], 1u);
    return b;
}
__device__ __forceinline__ void xcd_barrier_complete(unsigned* bar, unsigned x, unsigned& nloc, unsigned& nx) {
    const unsigned G = gridDim.x * gridDim.y * gridDim.z;
    unsigned sum, cnt, mine, sp = 0u;
    for (;;) {
        sum = 0u; cnt = 0u; mine = 0u;
#pragma unroll
        for (unsigned j = 0; j < 16; ++j) { const unsigned c = xb_ld(&bar[XB_XCNT(j)]); sum += c; cnt += (c > 0u) ? 1u : 0u; mine = (j == x) ? c : mine; }
        if (sum == G) break;
        __builtin_amdgcn_s_sleep(1);
        if ((++sp & 255u) == 0u) { if (xb_ld(&bar[XB_TMO])) break; if (sp > XB_SPIN_CAP) { atomicAdd(&bar[XB_TMO], 1u); break; } }
    }
    nloc = mine > 0u ? mine : 1u; nx = cnt > 0u ? cnt : 1u;
}
__device__ __forceinline__ void xcd_barrier(const XcdBarrier& b, const bool leader  ) {
    asm volatile("s_waitcnt vmcnt(0)" ::: "memory");
    __syncthreads();
    if (leader) {
        unsigned* bar = b.bar;
        __builtin_amdgcn_s_waitcnt(0);
        unsigned nloc = b.st[0], nx = b.st[1];
        if (nloc == 0u) { xcd_barrier_complete(bar, b.x, nloc, nx); b.st[0] = nloc; b.st[1] = nx; }
        const unsigned old = xb_add(&bar[XB_XSUB(b.x)], 1u);
        const unsigned gen = old / nloc;
        if (old + 1u == (gen + 1u) * nloc) {
            __builtin_amdgcn_fence(__ATOMIC_RELEASE, "agent");
            asm volatile("s_waitcnt vmcnt(0)" ::: "memory");
            const unsigned og = xb_add(&bar[XB_TOP], 1u);
            const unsigned tg = og / nx;
            if (og + 1u == (tg + 1u) * nx) xb_add(&bar[XB_TOPGEN], 1u);
            else XB_SPIN(xb_ld(&bar[XB_TOPGEN]) == tg, bar);
            __builtin_amdgcn_fence(__ATOMIC_ACQUIRE, "agent");
            xb_add(&bar[XB_XGEN(b.x)], 1u);
            asm volatile("s_waitcnt vmcnt(0)" ::: "memory");
        } else {
            XB_SPIN(xb_ld(&bar[XB_XGEN(b.x)]) == gen, bar);
            __builtin_amdgcn_fence(__ATOMIC_ACQUIRE, "agent");
            asm volatile("s_waitcnt vmcnt(0)" ::: "memory");
        }
    }
    __syncthreads();
}

__device__ __forceinline__ int fresh_lane() { int l; asm volatile("v_mbcnt_lo_u32_b32 %0, -1, 0\n\tv_mbcnt_hi_u32_b32 %0, -1, %0" : "=v"(l)); return l; }
#define LDS_WAIT() asm volatile("s_waitcnt lgkmcnt(0)" ::: "memory")
__device__ __forceinline__ unsigned f2bf(float f) { unsigned u = __builtin_bit_cast(unsigned, f); return (u + 0x7fffu + ((u >> 16) & 1u)) >> 16; }
__device__ __forceinline__ unsigned pk2(float lo, float hi) { return f2bf(lo) | (f2bf(hi) << 16); }
__device__ __forceinline__ float bfl(unsigned w) { return __uint_as_float(w << 16); }
__device__ __forceinline__ float bfh(unsigned w) { return __uint_as_float(w & 0xffff0000u); }
__device__ __forceinline__ float swz_xor(float v, int k) {
    switch (k) {
        case 1: return __int_as_float(__builtin_amdgcn_ds_swizzle(__float_as_int(v), 0x1F | (1 << 10)));
        case 2: return __int_as_float(__builtin_amdgcn_ds_swizzle(__float_as_int(v), 0x1F | (2 << 10)));
        case 4: return __int_as_float(__builtin_amdgcn_ds_swizzle(__float_as_int(v), 0x1F | (4 << 10)));
        case 8: return __int_as_float(__builtin_amdgcn_ds_swizzle(__float_as_int(v), 0x1F | (8 << 10)));
        default: return __int_as_float(__builtin_amdgcn_ds_swizzle(__float_as_int(v), 0x1F | (16 << 10)));
    }
}
__device__ __forceinline__ float xor32_sum(float v) { auto rr = __builtin_amdgcn_permlane32_swap(__float_as_uint(v), __float_as_uint(v), false, false); return __uint_as_float(rr[0]) + __uint_as_float(rr[1]); }
__device__ __forceinline__ float xor32_max(float v) { auto rr = __builtin_amdgcn_permlane32_swap(__float_as_uint(v), __float_as_uint(v), false, false); return fmaxf(__uint_as_float(rr[0]), __uint_as_float(rr[1])); }
__device__ __forceinline__ float wave_sum(float v) {
    v += swz_xor(v, 1); v += swz_xor(v, 2); v += swz_xor(v, 4); v += swz_xor(v, 8); v += swz_xor(v, 16);
    return xor32_sum(v);
}
__device__ __forceinline__ int t5_bucket(int rel) {
    const int d = rel < 0 ? -rel : rel;
    const int b = d < 8 ? d : d < 13 ? 8 : d < 20 ? 9 : d < 30 ? 10 : d < 46 ? 11 : d < 70 ? 12 : d < 108 ? 13 : d < 166 ? 14 : 15;
    return b + (rel > 0 ? 16 : 0);
}

struct Params {
    const float *x, *mem, *t5, *gains, *w_in, *a_rel, *ckv_gain, *w_uk, *w_uv, *sinks, *w_branch, *w_o, *mem_gain, *w_mq, *w_mkv, *w_mo, *w_up, *conv_w, *conv_b, *w_down;
    float* out; unsigned char* ws;
};
struct Frame { LAS unsigned char* lds; int tid, lane, wave, vcu, G, gw, NGW; };

template <class CSrc>
__device__ __forceinline__ void transpose_item(const float* W, int K, int N, bf16_t* WT, LAS float* scr, int item, int nblk, int lane, const CSrc& csrc) {
    const int kb = item / nblk, nb = item % nblk, k0 = 64 * kb, n0 = 32 * nb;
    const int cs = csrc(n0 + (lane & 31));
#pragma unroll 8
    for (int i = 0; i < 32; ++i) { const int kk = 2 * i + (lane >> 5); scr[kk * 33 + (lane & 31)] = cs >= 0 ? W[(size_t)(k0 + kk) * N + cs] : 0.f; }
    LDS_WAIT(); asm volatile("" ::: "memory");
    const int c = lane & 7;
#pragma unroll
    for (int j = 0; j < 4; ++j) { const int n = (lane >> 3) + 8 * j; const LAS float* s = scr + (8 * c) * 33 + n;
        u32x4 o; o.x = pk2(s[0 * 33], s[1 * 33]); o.y = pk2(s[2 * 33], s[3 * 33]); o.z = pk2(s[4 * 33], s[5 * 33]); o.w = pk2(s[6 * 33], s[7 * 33]);
        *(u32x4*)(WT + (size_t)(n0 + n) * K + k0 + 8 * c) = o; }
    LDS_WAIT(); asm volatile("" ::: "memory");
}
struct CsId { __device__ __forceinline__ int operator()(int n) const { return n; } };
struct CsIn { __device__ __forceinline__ int operator()(int n) const { return n < O_GLREAL ? n : n < O_GL ? -1 : n - (O_GL - O_GLREAL); } };

__device__ __forceinline__ void rms_row_to_bf16(const float* xrow, const float* g, bf16_t* orow, int lane) {
    const f32x4* xr = (const f32x4*)xrow + lane;
    f32x4 v[8]; float s = 0.f;
#pragma unroll
    for (int j = 0; j < 8; ++j) { v[j] = xr[64 * j]; s += (v[j].x * v[j].x + v[j].y * v[j].y) + (v[j].z * v[j].z + v[j].w * v[j].w); }
    const float r = 1.0f / sqrtf(wave_sum(s) * (1.0f / DM) + EPS);
    const f32x4* gr = (const f32x4*)g + lane;
    u32x2* o8 = (u32x2*)orow + lane;
#pragma unroll
    for (int j = 0; j < 8; ++j) { const f32x4 gg = gr[64 * j]; u32x2 w; w.x = pk2(v[j].x * r * gg.x, v[j].y * r * gg.y); w.y = pk2(v[j].z * r * gg.z, v[j].w * r * gg.w); o8[64 * j] = w; }
}
__device__ __forceinline__ void resnorm_row(const float* xin, const bf16_t* y, const float* g1, float* xout, const float* g2, bf16_t* hout, int lane) {
    const u32x2* yr = (const u32x2*)y + lane;
    f32x4 v[8]; float s = 0.f;
#pragma unroll
    for (int j = 0; j < 8; ++j) { const u32x2 w = yr[64 * j]; v[j] = (f32x4){bfl(w.x), bfh(w.x), bfl(w.y), bfh(w.y)}; s += (v[j].x * v[j].x + v[j].y * v[j].y) + (v[j].z * v[j].z + v[j].w * v[j].w); }
    const float r = 1.0f / sqrtf(wave_sum(s) * (1.0f / DM) + EPS);
    const f32x4* gr = (const f32x4*)g1 + lane; const f32x4* xr = (const f32x4*)xin + lane; f32x4* xo = (f32x4*)xout + lane;
    float s2 = 0.f;
#pragma unroll
    for (int j = 0; j < 8; ++j) { const f32x4 gg = gr[64 * j]; const f32x4 xx = xr[64 * j];
        v[j] = (f32x4){xx.x + v[j].x * r * gg.x, xx.y + v[j].y * r * gg.y, xx.z + v[j].z * r * gg.z, xx.w + v[j].w * r * gg.w};
        xo[64 * j] = v[j]; s2 += (v[j].x * v[j].x + v[j].y * v[j].y) + (v[j].z * v[j].z + v[j].w * v[j].w); }
    if (hout) {
        const float r2 = 1.0f / sqrtf(wave_sum(s2) * (1.0f / DM) + EPS);
        const f32x4* hr = (const f32x4*)g2 + lane; u32x2* o8 = (u32x2*)hout + lane;
#pragma unroll
        for (int j = 0; j < 8; ++j) { const f32x4 gg = hr[64 * j]; u32x2 w; w.x = pk2(v[j].x * r2 * gg.x, v[j].y * r2 * gg.y); w.y = pk2(v[j].z * r2 * gg.z, v[j].w * r2 * gg.w); o8[64 * j] = w; }
    }
}

__device__ __forceinline__ int pi32(int r) { return (r & ~12) | ((r & 4) << 1) | ((r & 8) >> 1); }
__device__ __forceinline__ int koff(int r, int hh) { return (r & 7) + 8 * hh + 16 * (r >> 3); }
__device__ __forceinline__ int crow(int r, int hh) { return (r & 3) + 8 * (r >> 2) + 4 * hh; }
__device__ __forceinline__ bf16x8 pack8(float a0, float a1, float a2, float a3, float a4, float a5, float a6, float a7) {
    u32x4 w; w.x = pg8::cvt_pk_bf16(a0, a1); w.y = pg8::cvt_pk_bf16(a2, a3); w.z = pg8::cvt_pk_bf16(a4, a5); w.w = pg8::cvt_pk_bf16(a6, a7);
    return __builtin_bit_cast(bf16x8, w);
}
typedef short v4i16_t __attribute__((ext_vector_type(4)));
__device__ __forceinline__ s16x4 vtr(const LAS unsigned char* p) { return __builtin_bit_cast(s16x4, __builtin_amdgcn_ds_read_tr16_b64_v4i16((LAS v4i16_t*)p)); }
#define MFMA32(a, b, c) __builtin_amdgcn_mfma_f32_32x32x16_bf16((a), (b), (c), 0, 0, 0)

template <int D> struct AttnCore {
    static constexpr int NQ = D / 16, NB = D / 32, VSTR = D * 2 + 16, NV = D / 16;
    f32x16 o[NB]; float m, l;
    __device__ __forceinline__ void init() {
#pragma unroll
        for (int b = 0; b < NB; ++b)
#pragma unroll
            for (int r = 0; r < 16; ++r) o[b][r] = 0.f;
        m = -1e30f; l = 0.f; }
    __device__ __forceinline__ void load_v(const bf16_t* vp, size_t ldv, int lane, u32x4 (&st)[NV]) const {
#pragma unroll
        for (int i = 0; i < NV; ++i) { const int idx = lane + 64 * i, row = idx / (D / 8), ch = idx % (D / 8); st[i] = *(const u32x4*)(vp + (size_t)row * ldv + ch * 8); }
    }
    __device__ __forceinline__ void write_v(LAS unsigned char* vb, int lane, const u32x4 (&st)[NV]) const {
#pragma unroll
        for (int i = 0; i < NV; ++i) { const int idx = lane + 64 * i, row = idx / (D / 8), ch = idx % (D / 8); *(LAS u32x4*)(vb + row * VSTR + ch * 16) = st[i]; }
    }
    __device__ __forceinline__ void softmax(f32x16& S, bf16x8& p0, bf16x8& p1) {
        float mx = fmaxf(fmaxf(S[0], S[1]), fmaxf(S[2], S[3]));
#pragma unroll
        for (int r = 4; r < 16; r += 4) mx = fmaxf(mx, fmaxf(fmaxf(S[r], S[r + 1]), fmaxf(S[r + 2], S[r + 3])));
        mx = xor32_max(mx);
        if (__any(mx > m)) {
            const float mn = fmaxf(m, mx), f = __builtin_amdgcn_exp2f(m - mn);
            l *= f;
#pragma unroll
            for (int b = 0; b < NB; ++b) o[b] = o[b] * f;
            m = mn;
        }
        float ls = 0.f;
#pragma unroll
        for (int r = 0; r < 16; ++r) { S[r] = __builtin_amdgcn_exp2f(S[r] - m); ls += S[r]; }
        l += ls;
        p0 = pack8(S[0], S[1], S[2], S[3], S[4], S[5], S[6], S[7]);
        p1 = pack8(S[8], S[9], S[10], S[11], S[12], S[13], S[14], S[15]);
    }
    __device__ __forceinline__ void pv(const LAS unsigned char* vb, int lane, bf16x8 p0, bf16x8 p1) {
        const int hh = lane >> 5, blk = (lane >> 4) & 1, q = (lane & 15) >> 2, p = lane & 3;
        const LAS unsigned char* base = vb + (8 * hh + q) * VSTR + (16 * blk + 4 * p) * 2;
#pragma unroll
        for (int b = 0; b < NB; ++b)
#pragma unroll
            for (int s = 0; s < 2; ++s) {
                const s16x4 lo = vtr(base + (16 * s) * VSTR + 64 * b), hi = vtr(base + (16 * s + 4) * VSTR + 64 * b);
                const bf16x8 a = (bf16x8){lo[0], lo[1], lo[2], lo[3], hi[0], hi[1], hi[2], hi[3]};
                o[b] = MFMA32(a, s ? p1 : p0, o[b]);
            }
    }
    __device__ __forceinline__ float lsum() const { return xor32_sum(l); }
};


__device__ __forceinline__ int sw128(int row) { return ((row & 3) << 2) | ((row >> 2) & 3); }
__device__ __forceinline__ int off128(int row, int ch) { return 256 * row + 16 * (ch ^ sw128(row)); }
struct AttnCore128 {
    static constexpr int NB = 4, TILE = 8192;
    f32x16 o[NB]; float m, l;
    __device__ __forceinline__ void init() {
#pragma unroll
        for (int b = 0; b < NB; ++b)
#pragma unroll
            for (int r = 0; r < 16; ++r) o[b][r] = 0.f;
        m = -1e30f; l = 0.f; }
    __device__ __forceinline__ void dma(const bf16_t* vp, unsigned ldv, int lane_, LAS unsigned char* buf) const {
        int lane = lane_; asm volatile("" : "+v"(lane));
        const unsigned rl = (unsigned)lane >> 4, cl = (unsigned)lane & 15u;
#pragma unroll
        for (int i = 0; i < 8; ++i) { const unsigned row = 4u * i + rl, ch = cl ^ ((rl << 2) | (unsigned)(i & 3));
            const unsigned voff = (row * ldv + ch * 8u) * 2u;
            __builtin_amdgcn_global_load_lds((const unsigned*)((const char*)vp + voff), (LAS unsigned*)(buf + 1024 * i), 16, 0, 0); }
    }
    __device__ __forceinline__ void softmax(f32x16& S, bf16x8& p0, bf16x8& p1) {
        float mx = fmaxf(fmaxf(S[0], S[1]), fmaxf(S[2], S[3]));
#pragma unroll
        for (int r = 4; r < 16; r += 4) mx = fmaxf(mx, fmaxf(fmaxf(S[r], S[r + 1]), fmaxf(S[r + 2], S[r + 3])));
        mx = xor32_max(mx);
        if (__any(mx > m)) {
            const float mn = fmaxf(m, mx), f = __builtin_amdgcn_exp2f(m - mn);
            l *= f;
#pragma unroll
            for (int b = 0; b < NB; ++b) o[b] = o[b] * f;
            m = mn;
        }
        float ls = 0.f;
#pragma unroll
        for (int r = 0; r < 16; ++r) { S[r] = __builtin_amdgcn_exp2f(S[r] - m); ls += S[r]; }
        l += ls;
        p0 = pack8(S[0], S[1], S[2], S[3], S[4], S[5], S[6], S[7]);
        p1 = pack8(S[8], S[9], S[10], S[11], S[12], S[13], S[14], S[15]);
    }
    __device__ __forceinline__ void pv(const LAS unsigned char* buf, int lane, bf16x8 p0, bf16x8 p1) {
        const int hh = lane >> 5, blk = (lane >> 4) & 1, q = (lane & 15) >> 2, p = lane & 3;
#pragma unroll
        for (int b = 0; b < NB; ++b)
#pragma unroll
            for (int s = 0; s < 2; ++s) {
                const s16x4 lo = vtr(buf + off128(16 * s + 8 * hh + q, 4 * b + 2 * blk + (p >> 1)) + 8 * (p & 1));
                const s16x4 hi = vtr(buf + off128(16 * s + 8 * hh + 4 + q, 4 * b + 2 * blk + (p >> 1)) + 8 * (p & 1));
                const bf16x8 a = (bf16x8){lo[0], lo[1], lo[2], lo[3], hi[0], hi[1], hi[2], hi[3]};
                o[b] = MFMA32(a, s ? p1 : p0, o[b]);
            }
    }
    __device__ __forceinline__ float lsum() const { return xor32_sum(l); }
};

template <int NQ> __device__ __forceinline__ void load_kfrags(const bf16_t* kp, size_t ldk, int lane, bf16x8 (&kf)[NQ]) {
    const bf16_t* rp = kp + (size_t)pi32(lane & 31) * ldk + 8 * (lane >> 5);
#pragma unroll
    for (int kk = 0; kk < NQ; ++kk) kf[kk] = *(const bf16x8*)(rp + 16 * kk);
}
template <int NQ> __device__ __forceinline__ void load_qfrags(const bf16_t* qp, size_t ldq, int lane, bf16x8 (&qf)[NQ]) {
    const bf16_t* rp = qp + (size_t)(lane & 31) * ldq + 8 * (lane >> 5);
#pragma unroll
    for (int kk = 0; kk < NQ; ++kk) qf[kk] = *(const bf16x8*)(rp + 16 * kk);
}
template <int NB> __device__ __forceinline__ void store_ot(const f32x16 (&o)[NB], float inv, bf16_t* op  , size_t ldo, int lane) {
    const int hh = lane >> 5; bf16_t* rp = op + (size_t)(lane & 31) * ldo + 4 * hh;
#pragma unroll
    for (int b = 0; b < NB; ++b)
#pragma unroll
        for (int g = 0; g < 4; ++g) { u32x2 w; w.x = pg8::cvt_pk_bf16(o[b][4 * g] * inv, o[b][4 * g + 1] * inv); w.y = pg8::cvt_pk_bf16(o[b][4 * g + 2] * inv, o[b][4 * g + 3] * inv);
            *(u32x2*)(rp + 32 * b + 8 * g) = w; }
}

__device__ __forceinline__ void attn_a_item(const bf16_t* P, const float* relb, bf16_t* cat, int item, int lane, LAS unsigned char* wl) {
    const int qh = item & 1, h = (item >> 1) & 7, c = (item >> 4) & 31, b = item >> 9;
    const int qpos0 = c * CHUNK + 32 * qh; const size_t q0 = (size_t)b * SEQ + qpos0;
    LAS float* tab = (LAS float*)(wl + 9216);
    for (int i = lane; i < 2 * A_MAXREL + 1; i += 64) tab[i] = relb[i * A_HEADS + h] * LOG2E;
    bf16x8 qf[4]; load_qfrags<4>(P + q0 * LDP + O_QA + h * 64, LDP, lane, qf);
    const bf16_t* Kp = P + (size_t)b * SEQ * LDP + O_KA + h * 64; const bf16_t* Vp = P + (size_t)b * SEQ * LDP + O_VA + h * 64;
    const int kbeg = (c - A_LEFT < 0 ? 0 : c - A_LEFT) * CHUNK, kend = (c + 1) * CHUNK;
    AttnCore<64> core; core.init();
    bf16x8 kf[4]; u32x4 vst[4];
    load_kfrags<4>(Kp + (size_t)kbeg * LDP, LDP, lane, kf);
    core.load_v(Vp + (size_t)kbeg * LDP, LDP, lane, vst);
    LDS_WAIT();
    core.write_v(wl, lane, vst);
    const int hh = lane >> 5, qpos = qpos0 + (lane & 31);
    const float SC = 0.125f * LOG2E;
    for (int kb = kbeg; kb < kend; kb += 32) {
        const bool has_next = kb + 32 < kend;
        f32x16 S;
#pragma unroll
        for (int r = 0; r < 16; ++r) S[r] = 0.f;
#pragma unroll
        for (int kk = 0; kk < 4; ++kk) S = MFMA32(kf[kk], qf[kk], S);
        if (has_next) { load_kfrags<4>(Kp + (size_t)(kb + 32) * LDP, LDP, lane, kf); core.load_v(Vp + (size_t)(kb + 32) * LDP, LDP, lane, vst); }
        if (kb + 31 + A_MAXREL <= qpos0) {
            const float bc = tab[2 * A_MAXREL];
#pragma unroll
            for (int r = 0; r < 16; ++r) S[r] = S[r] * SC + bc;
        } else {
#pragma unroll
            for (int r = 0; r < 16; ++r) { int rel = qpos - (kb + koff(r, hh)); rel = rel > A_MAXREL ? A_MAXREL : rel; S[r] = S[r] * SC + tab[rel + A_MAXREL]; }
        }
        bf16x8 p0, p1; core.softmax(S, p0, p1);
        core.pv(wl, lane, p0, p1);
        asm volatile("" ::: "memory");
        if (has_next) core.write_v(wl, lane, vst);
        asm volatile("" ::: "memory");
    }
    store_ot<2>(core.o, 1.0f / core.lsum(), cat + q0 * DM + h * 64, DM, lane);
    LDS_WAIT();
}

__device__ __forceinline__ void attn_c_item(const bf16_t* P, const float* t5, const float* sinks, bf16_t* cat, int item, int lane, LAS unsigned char* wl) {
    const int qh = item & 1, hq = (item >> 1) & 15, c = (item >> 5) & 31, b = item >> 10;
    const int kvh = hq >> 3;
    const int qpos0 = c * CHUNK + 32 * qh; const size_t q0 = (size_t)b * SEQ + qpos0;
    LAS float* tab = (LAS float*)(wl + 9216);
    for (int i = lane; i < 255; i += 64) tab[i] = t5[t5_bucket(i - 191) * NT5 + B_HEADS + hq] * LOG2E;
    bf16x8 qf[4]; load_qfrags<4>(P + q0 * LDP + O_QC + hq * 64, LDP, lane, qf);
    const bf16_t* Kp = P + (size_t)b * SEQ * LDP + O_KC + kvh * 64; const bf16_t* Vp = P + (size_t)b * SEQ * LDP + O_VC + kvh * 64;
    const int kbeg = (c - C_LEFT < 0 ? 0 : c - C_LEFT) * CHUNK, kend = (c + 1) * CHUNK;
    AttnCore<64> core; core.init();
    bf16x8 kf[4]; u32x4 vst[4];
    load_kfrags<4>(Kp + (size_t)kbeg * LDP, LDP, lane, kf);
    core.load_v(Vp + (size_t)kbeg * LDP, LDP, lane, vst);
    LDS_WAIT();
    core.write_v(wl, lane, vst);
    const int hh = lane >> 5, qpos = qpos0 + (lane & 31);
    const float SC = 0.125f * LOG2E;
    for (int kb = kbeg; kb < kend; kb += 32) {
        const bool has_next = kb + 32 < kend;
        f32x16 S;
#pragma unroll
        for (int r = 0; r < 16; ++r) S[r] = 0.f;
#pragma unroll
        for (int kk = 0; kk < 4; ++kk) S = MFMA32(kf[kk], qf[kk], S);
        if (has_next) { load_kfrags<4>(Kp + (size_t)(kb + 32) * LDP, LDP, lane, kf); core.load_v(Vp + (size_t)(kb + 32) * LDP, LDP, lane, vst); }
#pragma unroll
        for (int r = 0; r < 16; ++r) { const int rel = (kb + koff(r, hh)) - qpos; S[r] = S[r] * SC + tab[rel + 191]; }
        bf16x8 p0, p1; core.softmax(S, p0, p1);
        core.pv(wl, lane, p0, p1);
        asm volatile("" ::: "memory");
        if (has_next) core.write_v(wl, lane, vst);
        asm volatile("" ::: "memory");
    }
    const float sk = sinks[hq] * LOG2E, lt = core.lsum();
    const float m2 = fmaxf(core.m, sk), e1 = __builtin_amdgcn_exp2f(core.m - m2), e2 = __builtin_amdgcn_exp2f(sk - m2);
    store_ot<2>(core.o, e1 / (lt * e1 + e2), cat + q0 * DM + 1024 + hq * 64, DM, lane);
    LDS_WAIT();
}

__device__ __forceinline__ void attn_mem_item(const bf16_t* qm, const bf16_t* kvm, bf16_t* om, int item, int lane, LAS unsigned char* wl) {
    const int h = item & 3, j = (item >> 2) & 63, b = item >> 8;
    const size_t q0 = (size_t)b * SEQ + 32 * j;
    bf16x8 qf[8]; load_qfrags<8>(qm + q0 * MEM_W + h * MEM_HD, MEM_W, lane, qf);
    const bf16_t* Kp = kvm + (size_t)b * MEM_LEN * (2 * MEM_W) + h * MEM_HD; const bf16_t* Vp = Kp + MEM_W;
    AttnCore128 core; core.init();
    bf16x8 kf[8];
    LDS_WAIT();
    core.dma(Vp, 2 * MEM_W, lane, wl);
    load_kfrags<8>(Kp, 2 * MEM_W, lane, kf);
    const float SC = 0.08838834764831845f * LOG2E;
#pragma unroll 1
    for (int kb = 0; kb < MEM_LEN; kb += 32) {
        const bool has_next = kb + 32 < MEM_LEN;
        LAS unsigned char* buf = wl + ((kb >> 5) & 1) * AttnCore128::TILE;
        asm volatile("s_waitcnt vmcnt(0)" ::: "memory");
        if (has_next) core.dma(Vp + (size_t)(kb + 32) * (2 * MEM_W), 2 * MEM_W, lane, wl + (((kb >> 5) + 1) & 1) * AttnCore128::TILE);
        f32x16 S;
#pragma unroll
        for (int r = 0; r < 16; ++r) S[r] = 0.f;
#pragma unroll
        for (int kk = 0; kk < 8; ++kk) S = MFMA32(kf[kk], qf[kk], S);
        if (has_next) load_kfrags<8>(Kp + (size_t)(kb + 32) * (2 * MEM_W), 2 * MEM_W, lane, kf);
#pragma unroll
        for (int r = 0; r < 16; ++r) S[r] = S[r] * SC;
        bf16x8 p0, p1; core.softmax(S, p0, p1);
        core.pv(buf, lane, p0, p1);
        asm volatile("" ::: "memory");
    }
    store_ot<4>(core.o, 1.0f / core.lsum(), om + q0 * MEM_W + h * MEM_HD, MEM_W, lane);
    LDS_WAIT();
}

__device__ __forceinline__ void idx_score_item(const bf16_t* P, float* score, int item, int lane) {
    const int qh = item & 1; int i2 = item >> 1; const int b = i2 / 528, p = i2 % 528, a = p / 33, k = p % 33;
    int c, kc; if (k <= a + 16) { c = a + 16; kc = k; } else { c = 15 - a; kc = k - a - 17; }
    const size_t q0 = (size_t)b * SEQ + c * CHUNK + 32 * qh, k0 = (size_t)b * SEQ + kc * CHUNK;
    const int r32 = lane & 31, hh = lane >> 5;
    bf16x8 kf[2][4];
#pragma unroll
    for (int t = 0; t < 2; ++t)
#pragma unroll
        for (int kk = 0; kk < 4; ++kk) kf[t][kk] = *(const bf16x8*)(P + (k0 + 32 * t + r32) * LDP + O_KI + 16 * kk + 8 * hh);
    f32x16 sc[2];
#pragma unroll
    for (int t = 0; t < 2; ++t)
#pragma unroll
        for (int r = 0; r < 16; ++r) sc[t][r] = 0.f;
    const bf16_t* qrow = P + (q0 + r32) * LDP;
#pragma unroll 1
    for (int hd = 0; hd < IDX_HEADS; ++hd) {
        bf16x8 qf[4];
#pragma unroll
        for (int kk = 0; kk < 4; ++kk) qf[kk] = *(const bf16x8*)(qrow + O_QI + hd * 64 + 16 * kk + 8 * hh);
        const float w = __uint_as_float((unsigned)qrow[O_WI + hd] << 16) * (0.125f * 0.35355339059327373f);
#pragma unroll
        for (int t = 0; t < 2; ++t) {
            f32x16 S;
#pragma unroll
            for (int r = 0; r < 16; ++r) S[r] = 0.f;
#pragma unroll
            for (int kk = 0; kk < 4; ++kk) S = MFMA32(kf[t][kk], qf[kk], S);
#pragma unroll
            for (int r = 0; r < 16; ++r) sc[t][r] += fmaxf(S[r], 0.f) * w;
        }
    }
    float* srow = score + (q0 + r32) * SEQ + kc * CHUNK + 4 * hh;
#pragma unroll
    for (int t = 0; t < 2; ++t)
#pragma unroll
        for (int g = 0; g < 4; ++g) *(f32x4*)(srow + 32 * t + 8 * g) = (f32x4){sc[t][4 * g], sc[t][4 * g + 1], sc[t][4 * g + 2], sc[t][4 * g + 3]};
}

__device__ __forceinline__ void select_query(const float* score, unsigned* maskw, int t, int lane) {
    const int pos = t % SEQ, n = (pos / CHUNK + 1) * CHUNK;
    unsigned long long* mw = (unsigned long long*)(maskw + (size_t)t * 64);
    if (n <= TOPK) { unsigned long long ones = ~0ull; asm volatile("" : "+v"(ones)); if (lane < n / 64) mw[lane] = ones; return; }
    const int nreg = n / 64;
    unsigned key[32];
    const float* sr = score + (size_t)t * SEQ + lane;
#pragma unroll
    for (int i = 0; i < 32; ++i) { key[i] = 0u;
        if (i < nreg) { const float f = sr[64 * i] + 0.0f; const unsigned u = __float_as_uint(f); key[i] = (u & 0x80000000u) ? ~u : (u | 0x80000000u); } }
    unsigned T = 0u;
    for (int bit = 31; bit >= 0; --bit) {
        const unsigned cand = T | (1u << bit); int cnt = 0;
#pragma unroll
        for (int i = 0; i < 32; ++i) if (i < nreg) cnt += __builtin_popcountll(__ballot(key[i] >= cand));
        if (cnt >= TOPK) T = cand;
    }
    int gt = 0;
#pragma unroll
    for (int i = 0; i < 32; ++i) if (i < nreg) gt += __builtin_popcountll(__ballot(key[i] > T));
    int need = TOPK - gt;
#pragma unroll
    for (int i = 0; i < 32; ++i) if (i < nreg) {
        const unsigned long long eqm = __ballot(key[i] == T), gtm = __ballot(key[i] > T);
        unsigned long long take = gtm;
        if (eqm != 0ull && need > 0) {
            const int ne = __builtin_popcountll(eqm);
            if (ne <= need) { take |= eqm; need -= ne; }
            else { unsigned long long e = eqm; for (int k = 0; k < need; ++k) { const unsigned long long low = e & (~e + 1ull); take |= low; e ^= low; } need = 0; }
        }
        if (lane == 0) mw[i] = take;
    }
}

__device__ __forceinline__ void attn_b_item(const bf16_t* P, const bf16_t* ckvn, const unsigned* maskw, const bf16_t* wuk  , const bf16_t* wuvt  , const float* t5,
                                            bf16_t* cat, int b, int j, int h, int lane, LAS unsigned char* wl, LAS float* tab) {
    const int qpos0 = 32 * j, n = (j / 2 + 1) * CHUNK; const size_t q0 = (size_t)b * SEQ + qpos0;
    const int r32 = lane & 31, hh = lane >> 5, qpos = qpos0 + r32;
    for (int i = lane; i < 229; i += 64) tab[i] = t5[t5_bucket(i - 165) * NT5 + h] * LOG2E;
    const float bfar = t5[15 * NT5 + h] * LOG2E;
    bf16x8 qlf[4][2];
    {
        bf16x8 qf[4]; load_qfrags<4>(P + q0 * LDP + O_QB + h * 64, LDP, lane, qf);
        const float SC = 0.125f * LOG2E;
#pragma unroll
        for (int cb = 0; cb < 4; ++cb) {
            f32x16 X;
#pragma unroll
            for (int r = 0; r < 16; ++r) X[r] = 0.f;
            const bf16_t* wp = wuk + ((size_t)h * B_LAT + 32 * cb + r32) * 64 + 8 * hh;
#pragma unroll
            for (int kk = 0; kk < 4; ++kk) X = MFMA32(*(const bf16x8*)(wp + 16 * kk), qf[kk], X);
            qlf[cb][0] = pack8(X[0] * SC, X[1] * SC, X[2] * SC, X[3] * SC, X[4] * SC, X[5] * SC, X[6] * SC, X[7] * SC);
            qlf[cb][1] = pack8(X[8] * SC, X[9] * SC, X[10] * SC, X[11] * SC, X[12] * SC, X[13] * SC, X[14] * SC, X[15] * SC);
        }
    }
    AttnCore128 core; core.init();
    const bf16_t* Cp = ckvn + (size_t)b * SEQ * B_LAT;
    LDS_WAIT();
    core.dma(Cp, B_LAT, lane, wl);
    const unsigned* mrow = maskw + (q0 + r32) * 64;
    const int krow = pi32(r32);
#pragma unroll 1
    for (int kb = 0; kb < n; kb += 32) {
        const bool has_next = kb + 32 < n;
        const LAS unsigned char* buf = wl + ((kb >> 5) & 1) * AttnCore128::TILE;
        asm volatile("s_waitcnt vmcnt(0)" ::: "memory");
        if (has_next) core.dma(Cp + (size_t)(kb + 32) * B_LAT, B_LAT, lane, wl + (((kb >> 5) + 1) & 1) * AttnCore128::TILE);
        const unsigned mwd = mrow[kb >> 5];
        f32x16 S;
#pragma unroll
        for (int r = 0; r < 16; ++r) S[r] = 0.f;
#pragma unroll
        for (int cb = 0; cb < 4; ++cb)
#pragma unroll
            for (int s = 0; s < 2; ++s) S = MFMA32(*(const LAS bf16x8*)(buf + off128(krow, 4 * cb + 2 * s + hh)), qlf[cb][s], S);
        if (kb + 31 + 166 <= qpos0) {
#pragma unroll
            for (int r = 0; r < 16; ++r) S[r] = ((mwd >> koff(r, hh)) & 1u) ? S[r] + bfar : -1e30f;
        } else {
#pragma unroll
            for (int r = 0; r < 16; ++r) { const int rel = (kb + koff(r, hh)) - qpos; const float tv = tab[rel < -165 ? 0 : rel + 165]; const float bv = rel < -165 ? bfar : tv;
                S[r] = ((mwd >> koff(r, hh)) & 1u) ? S[r] + bv : -1e30f; }
        }
        bf16x8 p0, p1; core.softmax(S, p0, p1);
        core.pv(buf, lane, p0, p1);
        asm volatile("" ::: "memory");
    }
    const float inv = 1.0f / core.lsum();
    f32x16 ot[2];
#pragma unroll
    for (int db = 0; db < 2; ++db) {
#pragma unroll
        for (int r = 0; r < 16; ++r) ot[db][r] = 0.f;
        const bf16_t* wp = wuvt + ((size_t)h * 64 + 32 * db + r32) * B_LAT + 8 * hh;
#pragma unroll
        for (int cb = 0; cb < 4; ++cb) {
            const bf16x8 x0 = pack8(core.o[cb][0], core.o[cb][1], core.o[cb][2], core.o[cb][3], core.o[cb][4], core.o[cb][5], core.o[cb][6], core.o[cb][7]);
            const bf16x8 x1 = pack8(core.o[cb][8], core.o[cb][9], core.o[cb][10], core.o[cb][11], core.o[cb][12], core.o[cb][13], core.o[cb][14], core.o[cb][15]);
            ot[db] = MFMA32(*(const bf16x8*)(wp + 32 * cb), x0, ot[db]);
            ot[db] = MFMA32(*(const bf16x8*)(wp + 32 * cb + 16), x1, ot[db]);
        }
    }
    store_ot<2>(ot, inv, cat + q0 * DM + 512 + h * 64, DM, lane);
    LDS_WAIT();
}

__device__ __forceinline__ void ckvn_row(const bf16_t* P, const float* gain, bf16_t* ckvn, int t, int lane) {
    const unsigned w = *(const unsigned*)(P + (size_t)t * LDP + O_CKV + 2 * lane);
    const float a = bfl(w), bb = bfh(w);
    const float r = 1.0f / sqrtf(wave_sum(a * a + bb * bb) * (1.0f / B_LAT) + EPS);
    const int c = 2 * lane, pc = (c & ~12) | ((c & 4) << 1) | ((c & 8) >> 1);
    *(unsigned*)(ckvn + (size_t)t * B_LAT + pc) = pk2(a * r * gain[c], bb * r * gain[c + 1]);
}

__device__ __forceinline__ float gelu_tanh_fast(float x) {
    const float z = 0.7978845608028654f * (x + 0.044715f * x * x * x);
    return x * __builtin_amdgcn_rcpf(1.0f + __builtin_amdgcn_exp2f(-2.0f * LOG2E * z));
}
__device__ __forceinline__ void conv_item(const bf16_t* u, const float* cw, const float* cb, bf16_t* act, int item, int lane) {
    const int strip = item % 22, seg = item / 22;
    const int c0 = strip * 256 + 4 * lane;
    if (c0 >= DFF) return;
    const int r0 = seg * 32;
    const f32x4 wg0 = *(const f32x4*)(cw + c0), wg1 = *(const f32x4*)(cw + 2 * DFF + c0), wg2 = *(const f32x4*)(cw + 4 * DFF + c0);
    const f32x4 wv0 = *(const f32x4*)(cw + DFF + c0), wv1 = *(const f32x4*)(cw + 3 * DFF + c0), wv2 = *(const f32x4*)(cw + 5 * DFF + c0);
    const f32x4 bg = *(const f32x4*)(cb + c0), bv = *(const f32x4*)(cb + DFF + c0);
    f32x4 g1 = (f32x4){0.f, 0.f, 0.f, 0.f}, g2 = g1, v1 = g1, v2 = g1;
    if ((r0 % SEQ) != 0) {
        const u32x2 a1 = *(const u32x2*)(u + (size_t)(r0 - 1) * (2 * DFF) + c0), a2 = *(const u32x2*)(u + (size_t)(r0 - 2) * (2 * DFF) + c0);
        const u32x2 b1 = *(const u32x2*)(u + (size_t)(r0 - 1) * (2 * DFF) + DFF + c0), b2 = *(const u32x2*)(u + (size_t)(r0 - 2) * (2 * DFF) + DFF + c0);
        g1 = (f32x4){bfl(a1.x), bfh(a1.x), bfl(a1.y), bfh(a1.y)}; g2 = (f32x4){bfl(a2.x), bfh(a2.x), bfl(a2.y), bfh(a2.y)};
        v1 = (f32x4){bfl(b1.x), bfh(b1.x), bfl(b1.y), bfh(b1.y)}; v2 = (f32x4){bfl(b2.x), bfh(b2.x), bfl(b2.y), bfh(b2.y)};
    }
#pragma unroll 4
    for (int r = r0; r < r0 + 32; ++r) {
        const u32x2 a0 = *(const u32x2*)(u + (size_t)r * (2 * DFF) + c0), b0 = *(const u32x2*)(u + (size_t)r * (2 * DFF) + DFF + c0);
        const f32x4 g0 = (f32x4){bfl(a0.x), bfh(a0.x), bfl(a0.y), bfh(a0.y)}, v0 = (f32x4){bfl(b0.x), bfh(b0.x), bfl(b0.y), bfh(b0.y)};
        const f32x4 ga = bg + g2 * wg0 + g1 * wg1 + g0 * wg2, va = bv + v2 * wv0 + v1 * wv1 + v0 * wv2;
        u32x2 w; w.x = pg8::cvt_pk_bf16(gelu_tanh_fast(ga.x) * va.x, gelu_tanh_fast(ga.y) * va.y); w.y = pg8::cvt_pk_bf16(gelu_tanh_fast(ga.z) * va.z, gelu_tanh_fast(ga.w) * va.w);
        *(u32x2*)(act + (size_t)r * DFF + c0) = w;
        g2 = g1; g1 = g0; v2 = v1; v1 = v0;
    }
}

struct SchedBranch {
    const bf16_t* A; const bf16_t* Bt; int G, c;
    __device__ __forceinline__ bool next(int i, pg8::Unit& u) const {
        const int seg = i % 3;
        if (!pg8::tile_order(MROWS / 256, DM / 256, G, c, i / 3, u.pm, u.pn)) return false;
        const int k0 = seg == 0 ? 0 : seg == 1 ? 512 : 1024;
        u.nt = seg == 2 ? 16 : 8; u.tag = seg | (seg < 2 ? pg8::TAG_KEEP : 0);
        u.A = (const char*)(A + (size_t)u.pm * 256 * DM + k0); u.B = (const char*)(Bt + (size_t)u.pn * 256 * DM + k0); return true;
    }
};
struct SchedMemProj {
    const bf16_t* H; const bf16_t* WqT; const bf16_t* MemN; const bf16_t* WkvT; int G, c;
    __device__ __forceinline__ bool next(int i, pg8::Unit& u) const {
        const int L = i * G + c; if (L >= 80) return false;
        u.nt = DM / 64;
        if (L < 64) { u.pm = L % 32; u.pn = L / 32; u.tag = 0; u.A = (const char*)(H + (size_t)u.pm * 256 * DM); u.B = (const char*)(WqT + (size_t)u.pn * 256 * DM); }
        else { const int t = L - 64; u.pm = t % 4; u.pn = t / 4; u.tag = 1; u.A = (const char*)(MemN + (size_t)u.pm * 256 * DM); u.B = (const char*)(WkvT + (size_t)u.pn * 256 * DM); }
        return true;
    }
};

__device__ __forceinline__ unsigned char* lds_ptr_entry(LAS unsigned char* lds0, int i) {
    unsigned off = LDSCTL_OFF + 512; asm volatile("" : "+s"(off));
    const unsigned long long v = *(volatile LAS unsigned long long*)(lds0 + off + 8 * i);
    return (unsigned char*)(((unsigned long long)(unsigned)__builtin_amdgcn_readfirstlane((int)(v >> 32)) << 32) | (unsigned long long)(unsigned)__builtin_amdgcn_readfirstlane((int)(v & 0xffffffffull)));
}

__global__ void __launch_bounds__(NWAVES * 64, 2) fwd_kernel(Params p) {
    extern __shared__ __attribute__((aligned(16))) unsigned char lds_raw[];
    Frame F;
    F.lds = (LAS unsigned char*)lds_raw;
    F.tid = threadIdx.x; F.lane = F.tid & 63; F.wave = __builtin_amdgcn_readfirstlane(F.tid >> 6);
    F.G = gridDim.x; { const int bx = blockIdx.x; F.vcu = (F.G % 8 == 0) ? (bx % 8) * (F.G / 8) + bx / 8 : bx; }
    F.gw = F.vcu * NWAVES + F.wave; F.NGW = F.G * NWAVES;
    volatile LAS unsigned* MISC = (volatile LAS unsigned*)(F.lds + MISC_OFF);
    for (int u = F.tid; u < (LDS_BYTES - LDSCTL_OFF) / 4; u += NWAVES * 64) ((LAS unsigned*)(F.lds + LDSCTL_OFF))[u] = 0u;
    __syncthreads();
    volatile LAS unsigned long long* PT = (volatile LAS unsigned long long*)(F.lds + LDSCTL_OFF + 512);
    if (F.tid == 0) {
        PT[0] = (unsigned long long)p.x;
        PT[1] = (unsigned long long)p.mem;
        PT[2] = (unsigned long long)p.t5;
        PT[3] = (unsigned long long)p.gains;
        PT[4] = (unsigned long long)p.w_in;
        PT[5] = (unsigned long long)p.a_rel;
        PT[6] = (unsigned long long)p.ckv_gain;
        PT[7] = (unsigned long long)p.w_uk;
        PT[8] = (unsigned long long)p.w_uv;
        PT[9] = (unsigned long long)p.sinks;
        PT[10] = (unsigned long long)p.w_branch;
        PT[11] = (unsigned long long)p.w_o;
        PT[12] = (unsigned long long)p.mem_gain;
        PT[13] = (unsigned long long)p.w_mq;
        PT[14] = (unsigned long long)p.w_mkv;
        PT[15] = (unsigned long long)p.w_mo;
        PT[16] = (unsigned long long)p.w_up;
        PT[17] = (unsigned long long)p.conv_w;
        PT[18] = (unsigned long long)p.conv_b;
        PT[19] = (unsigned long long)p.w_down;
        PT[20] = (unsigned long long)p.out;
        PT[21] = (unsigned long long)p.ws;
    }
    __syncthreads();
#define PTR(i) lds_ptr_entry(F.lds, (i))
#define ws PTR(21)
    (void)xcd_barrier_post((unsigned*)(ws + WS_CTL) + CW_BAR, MISC + 8);
#define GRID_BAR() do { unsigned char* wsb = ws; asm volatile("" : "+s"(wsb)); XcdBarrier b_; b_.bar = (unsigned*)(wsb + WS_CTL) + CW_BAR; b_.x = xb_xcc_id(); b_.st = MISC + 8; xcd_barrier(b_, F.wave == 0 && fresh_lane() == 0); } while (0)
    const int gw0 = F.gw, NGW0 = F.NGW;
#define FRESH_LANE() const int lane = fresh_lane()

#define PHASE_BEGIN() unsigned char* wsp = ws; int lp = l_, gw = gw0, NGW = NGW0, wvi = F.wave, Gp = F.G, bxp = (int)blockIdx.x; asm volatile("" : "+s"(wsp), "+s"(lp), "+s"(gw), "+s"(NGW), "+s"(wvi), "+s"(Gp), "+s"(bxp)); LAS unsigned char* wl = F.lds + wvi * WAVE_LDS; (void)wl; (void)gw; (void)NGW; (void)Gp; (void)bxp
#define Hb ((bf16_t*)(wsp + WS_H))
#define Pb ((bf16_t*)(wsp + WS_BIG))
#define CATb ((bf16_t*)(wsp + WS_CAT))
#define QMb CATb
#define OMb (CATb + (size_t)MROWS * MEM_W)
#define MRGb ((bf16_t*)(wsp + WS_MRG))
#define SCOREf ((float*)(wsp + WS_MRG))
#define Yb ((bf16_t*)(wsp + WS_Y))
#define ACTb ((bf16_t*)(wsp + WS_ACT))
#define CKVNb ((bf16_t*)(wsp + WS_CKVN))
#define MASKw ((unsigned*)(wsp + WS_MASK))
#define KVMb ((bf16_t*)(wsp + WS_KVM) + (size_t)lp * 1024 * 1024)
#define WLB (wsp + WS_W0 + (size_t)lp * WL_SIZE)

    {
        const int l_ = 0; FRESH_LANE(); PHASE_BEGIN(); (void)lp;
        LAS float* scr = (LAS float*)wl;
        for (int l = 0; l < DEPTH; ++l) {
            unsigned char* wlb = wsp + WS_W0 + (size_t)l * WL_SIZE;
            constexpr int I_IN = (DM / 64) * (LDP / 32), I_BR = (DM / 64) * (DM / 32), I_O = I_BR, I_MQ = (DM / 64) * (MEM_W / 32), I_MKV = (DM / 64) * (2 * MEM_W / 32),
                          I_MO = (MEM_W / 64) * (DM / 32), I_UP = (DM / 64) * (2 * DFF / 32), I_DN = (DFF / 64) * (DM / 32);
            constexpr int NITEMS = I_IN + I_BR + I_O + I_MQ + I_MKV + I_MO + I_UP + I_DN;
            for (int it = gw; it < NITEMS; it += NGW) {
                int r = it;
                if (r < I_IN) { transpose_item(((const float*)PTR(4)) + (size_t)l * DM * IN_W, DM, IN_W, (bf16_t*)(wlb + WL_IN), scr, r, LDP / 32, lane, CsIn()); continue; } r -= I_IN;
                if (r < I_BR) { transpose_item(((const float*)PTR(10)) + (size_t)l * DM * DM, DM, DM, (bf16_t*)(wlb + WL_BR), scr, r, DM / 32, lane, CsId()); continue; } r -= I_BR;
                if (r < I_O) { transpose_item(((const float*)PTR(11)) + (size_t)l * DM * DM, DM, DM, (bf16_t*)(wlb + WL_O), scr, r, DM / 32, lane, CsId()); continue; } r -= I_O;
                if (r < I_MQ) { transpose_item(((const float*)PTR(13)) + (size_t)l * DM * MEM_W, DM, MEM_W, (bf16_t*)(wlb + WL_MQ), scr, r, MEM_W / 32, lane, CsId()); continue; } r -= I_MQ;
                if (r < I_MKV) { transpose_item(((const float*)PTR(14)) + (size_t)l * DM * 2 * MEM_W, DM, 2 * MEM_W, (bf16_t*)(wlb + WL_MKV), scr, r, 2 * MEM_W / 32, lane, CsId()); continue; } r -= I_MKV;
                if (r < I_MO) { transpose_item(((const float*)PTR(15)) + (size_t)l * MEM_W * DM, MEM_W, DM, (bf16_t*)(wlb + WL_MO), scr, r, DM / 32, lane, CsId()); continue; } r -= I_MO;
                if (r < I_UP) { transpose_item(((const float*)PTR(16)) + (size_t)l * DM * 2 * DFF, DM, 2 * DFF, (bf16_t*)(wlb + WL_UP), scr, r, 2 * DFF / 32, lane, CsId()); continue; } r -= I_UP;
                transpose_item(((const float*)PTR(19)) + (size_t)l * DFF * DM, DFF, DM, (bf16_t*)(wlb + WL_DN), scr, r, DM / 32, lane, CsId());
            }
        }
        const int gt = gw * 64 + lane, NGT = NGW * 64;
        for (int i = gt; i < DEPTH * 8 * 128 * 64; i += NGT) {
            ((bf16_t*)(wsp + WS_WUK))[i] = (bf16_t)f2bf(((const float*)PTR(7))[i]);
            const int c = i & 127, d = (i >> 7) & 63, lh = i >> 13;
            ((bf16_t*)(wsp + WS_WUVT))[i] = (bf16_t)f2bf(((const float*)PTR(8))[((size_t)lh * 128 + c) * 64 + d]);
        }
        for (int r = gw; r < DEPTH * NBATCH * MEM_LEN; r += NGW) { const int l = r / (NBATCH * MEM_LEN), mr = r % (NBATCH * MEM_LEN);
            rms_row_to_bf16(((const float*)PTR(1)) + (size_t)mr * DM, ((const float*)PTR(12)) + (size_t)l * DM, (bf16_t*)(wsp + WS_MEMN) + (size_t)r * DM, lane); }
        for (int r = gw; r < MROWS; r += NGW) rms_row_to_bf16(((const float*)PTR(0)) + (size_t)r * DM, ((const float*)PTR(3)), Hb + (size_t)r * DM, lane);
    }
    GRID_BAR();

    for (int l_ = 0; l_ < DEPTH; ++l_) {
        {
            PHASE_BEGIN();
            pg8::SchedGrid S{Hb, (const bf16_t*)(WLB + WL_IN), MROWS / 256, LDP / 256, DM, Gp, bxp};
            pg8::EpiStore E{Pb, LDP, O_GL / 256, nullptr, 0};
            pg8::gemm_phase(F.lds, DM, S, E, wvi, fresh_lane());
        }
        GRID_BAR();
        {
            FRESH_LANE(); PHASE_BEGIN();
            const float* relb = ((const float*)PTR(5)) + (size_t)lp * (2 * A_MAXREL + 1) * A_HEADS;
            for (int it = gw; it < NBATCH * 32 * A_HEADS * 2; it += NGW) attn_a_item(Pb, relb, CATb, it, lane, wl);
            for (int it = gw; it < NBATCH * 32 * C_QH * 2; it += NGW) attn_c_item(Pb, ((const float*)PTR(2)), ((const float*)PTR(9)) + (size_t)lp * C_QH, CATb, it, lane, wl);
            for (int it = gw; it < NBATCH * 528 * 2; it += NGW) idx_score_item(Pb, SCOREf, it, lane);
            for (int t = gw; t < MROWS; t += NGW) ckvn_row(Pb, ((const float*)PTR(6)) + (size_t)lp * B_LAT, CKVNb, t, lane);
        }
        GRID_BAR();
        { FRESH_LANE(); PHASE_BEGIN(); const float* g = ((const float*)PTR(3)) + (size_t)lp * 6 * DM; (void)g;
        for (int q = gw; q < 2048; q += NGW) {
            const int pp = q & 1023, bp = q >> 10;
            select_query(SCOREf, MASKw, (2 * bp) * SEQ + pp, lane); select_query(SCOREf, MASKw, (2 * bp) * SEQ + (SEQ - 1 - pp), lane);
            select_query(SCOREf, MASKw, (2 * bp + 1) * SEQ + pp, lane); select_query(SCOREf, MASKw, (2 * bp + 1) * SEQ + (SEQ - 1 - pp), lane);
        } }
        GRID_BAR();
        { FRESH_LANE(); PHASE_BEGIN(); const float* g = ((const float*)PTR(3)) + (size_t)lp * 6 * DM; (void)g;
        for (int q = gw; q < 2048; q += NGW) {
            const int wv = q & 7, gq = q >> 3, pr = gq * 4 + (wv & 3), b = pr >> 8, rem = pr & 255, jj = rem >> 3, h = rem & 7, j = (wv >> 2) ? 63 - jj : jj;
            attn_b_item(Pb, CKVNb, MASKw, (const bf16_t*)(wsp + WS_WUK) + (size_t)lp * 8 * 128 * 64, (const bf16_t*)(wsp + WS_WUVT) + (size_t)lp * 8 * 128 * 64, ((const float*)PTR(2)), CATb, b, j, h, lane, wl, (LAS float*)(F.lds + LDSCTL_OFF + 1024 + wvi * 1280));
        } }
        GRID_BAR();
        {
            PHASE_BEGIN();
            SchedBranch S{CATb, (const bf16_t*)(WLB + WL_BR), Gp, bxp};
            pg8::EpiBranch E{Pb + O_GL, LDP, MRGb, DM};
            pg8::gemm_phase(F.lds, DM, S, E, wvi, fresh_lane());
        }
        GRID_BAR();
        {
            PHASE_BEGIN();
            pg8::SchedGrid S{MRGb, (const bf16_t*)(WLB + WL_O), MROWS / 256, DM / 256, DM, Gp, bxp};
            pg8::EpiStore E{Yb, DM, 1 << 30, nullptr, 0};
            pg8::gemm_phase(F.lds, DM, S, E, wvi, fresh_lane());
        }
        GRID_BAR();
        { FRESH_LANE(); PHASE_BEGIN(); const float* g = ((const float*)PTR(3)) + (size_t)lp * 6 * DM; (void)g;
        for (int r = gw; r < MROWS; r += NGW) resnorm_row((lp == 0 ? ((const float*)PTR(0)) : ((float*)PTR(20))) + (size_t)r * DM, Yb + (size_t)r * DM, g + DM, ((float*)PTR(20)) + (size_t)r * DM, g + 2 * DM, Hb + (size_t)r * DM, lane); }
        GRID_BAR();
        {
            PHASE_BEGIN();
            SchedMemProj S{Hb, (const bf16_t*)(WLB + WL_MQ), (const bf16_t*)(wsp + WS_MEMN) + (size_t)lp * 1024 * DM, (const bf16_t*)(WLB + WL_MKV), Gp, bxp};
            pg8::EpiStore E{QMb, MEM_W, 1 << 30, KVMb, 2 * MEM_W};
            pg8::gemm_phase(F.lds, DM, S, E, wvi, fresh_lane());
        }
        GRID_BAR();
        { FRESH_LANE(); PHASE_BEGIN(); for (int it = gw; it < NBATCH * 64 * MEM_HEADS; it += NGW) attn_mem_item(QMb, KVMb, OMb, it, lane, wl); }
        GRID_BAR();
        {
            PHASE_BEGIN();
            pg8::SchedGrid S{OMb, (const bf16_t*)(WLB + WL_MO), MROWS / 256, DM / 256, MEM_W, Gp, bxp};
            pg8::EpiStore E{Yb, DM, 1 << 30, nullptr, 0};
            pg8::gemm_phase(F.lds, MEM_W, S, E, wvi, fresh_lane());
        }
        GRID_BAR();
        { FRESH_LANE(); PHASE_BEGIN(); const float* g = ((const float*)PTR(3)) + (size_t)lp * 6 * DM; (void)g;
        for (int r = gw; r < MROWS; r += NGW) resnorm_row(((float*)PTR(20)) + (size_t)r * DM, Yb + (size_t)r * DM, g + 3 * DM, ((float*)PTR(20)) + (size_t)r * DM, g + 4 * DM, Hb + (size_t)r * DM, lane); }
        GRID_BAR();
        {
            PHASE_BEGIN();
            pg8::SchedGrid S{Hb, (const bf16_t*)(WLB + WL_UP), MROWS / 256, 2 * DFF / 256, DM, Gp, bxp};
            pg8::EpiStore E{Pb, 2 * DFF, 1 << 30, nullptr, 0};
            pg8::gemm_phase(F.lds, DM, S, E, wvi, fresh_lane());
        }
        GRID_BAR();
        { FRESH_LANE(); PHASE_BEGIN(); for (int it = gw; it < 22 * (MROWS / 32); it += NGW) conv_item(Pb, ((const float*)PTR(17)) + (size_t)lp * 3 * 2 * DFF, ((const float*)PTR(18)) + (size_t)lp * 2 * DFF, ACTb, it, lane); }
        GRID_BAR();
        {
            PHASE_BEGIN();
            pg8::SchedGrid S{ACTb, (const bf16_t*)(WLB + WL_DN), MROWS / 256, DM / 256, DFF, Gp, bxp};
            pg8::EpiStore E{Yb, DM, 1 << 30, nullptr, 0};
            pg8::gemm_phase(F.lds, DFF, S, E, wvi, fresh_lane());
        }
        GRID_BAR();
        {
            FRESH_LANE(); PHASE_BEGIN(); const float* g = ((const float*)PTR(3)) + (size_t)lp * 6 * DM;
            const float* gn = ((const float*)PTR(3)) + (size_t)(lp + 1 < DEPTH ? lp + 1 : lp) * 6 * DM;
            for (int r = gw; r < MROWS; r += NGW) resnorm_row(((float*)PTR(20)) + (size_t)r * DM, Yb + (size_t)r * DM, g + 5 * DM, ((float*)PTR(20)) + (size_t)r * DM, gn, (lp + 1 < DEPTH) ? Hb + (size_t)r * DM : nullptr, lane);
        }
        if (l_ + 1 < DEPTH) GRID_BAR();
    }
}

#undef ws
#undef PTR
extern "C" void kernel_launch(void* const* d_in, const int* in_sizes, int n_in, void* d_out, int out_size, void* d_ws, size_t ws_size, hipStream_t stream) {
    static int grid = 0;
    if (grid == 0) {
        if (n_in != 20 || in_sizes[0] != MROWS * DM || out_size != MROWS * DM || ws_size < WS_END) {
            fprintf(stderr, "kernel_launch: unexpected problem (n_in %d, in0 %d, out %d, ws %zu, need %zu); nothing launched\n", n_in, n_in > 0 ? in_sizes[0] : -1, out_size, ws_size, (size_t)WS_END); grid = -1; return; }
        int dev = 0, cus = 0, per_cu = 0;
        if (hipGetDevice(&dev) != hipSuccess || hipDeviceGetAttribute(&cus, hipDeviceAttributeMultiprocessorCount, dev) != hipSuccess) { fprintf(stderr, "kernel_launch: device query failed\n"); grid = -1; return; }
        if (hipFuncSetAttribute((const void*)fwd_kernel, hipFuncAttributeMaxDynamicSharedMemorySize, LDS_BYTES) != hipSuccess) { fprintf(stderr, "kernel_launch: hipFuncSetAttribute failed\n"); grid = -1; return; }
        if (hipOccupancyMaxActiveBlocksPerMultiprocessor(&per_cu, (const void*)fwd_kernel, NWAVES * 64, LDS_BYTES) != hipSuccess || per_cu < 1)
            fprintf(stderr, "kernel_launch: note: the occupancy query reports %d workgroups per CU\n", per_cu);
        (void)hipGetLastError();
        grid = cus;
    }
    if (grid < 0) return;
    if (hipMemsetAsync((char*)d_ws + WS_CTL, 0, CTL_ZERO_BYTES, stream) != hipSuccess) { fprintf(stderr, "kernel_launch: memset failed\n"); return; }
    Params p{};
    p.x = (const float*)d_in[0]; p.mem = (const float*)d_in[1]; p.t5 = (const float*)d_in[2]; p.gains = (const float*)d_in[3]; p.w_in = (const float*)d_in[4];
    p.a_rel = (const float*)d_in[5]; p.ckv_gain = (const float*)d_in[6]; p.w_uk = (const float*)d_in[7]; p.w_uv = (const float*)d_in[8]; p.sinks = (const float*)d_in[9];
    p.w_branch = (const float*)d_in[10]; p.w_o = (const float*)d_in[11]; p.mem_gain = (const float*)d_in[12]; p.w_mq = (const float*)d_in[13]; p.w_mkv = (const float*)d_in[14];
    p.w_mo = (const float*)d_in[15]; p.w_up = (const float*)d_in[16]; p.conv_w = (const float*)d_in[17]; p.conv_b = (const float*)d_in[18]; p.w_down = (const float*)d_in[19];
    p.out = (float*)d_out; p.ws = (unsigned char*)d_ws;
    hipLaunchKernelGGL(fwd_kernel, dim3(grid), dim3(NWAVES * 64), LDS_BYTES, stream, p);
    const hipError_t le = hipPeekAtLastError();
    if (le != hipSuccess) fprintf(stderr, "kernel_launch: launch failed: %s\n", hipGetErrorName(le));
}
```

```cpp
#include <hip/hip_runtime.h>
#include <hip/hip_bf16.h>
#include <cstdio>
#include <cstdint>
#include <cmath>

#define GAS __attribute__((address_space(1)))
#define LAS __attribute__((address_space(3)))
typedef unsigned short bf16_t;
typedef short bf16x8 __attribute__((ext_vector_type(8)));
typedef short s16x4 __attribute__((ext_vector_type(4)));
typedef float f32x2 __attribute__((ext_vector_type(2)));
typedef float f32x4 __attribute__((ext_vector_type(4)));
typedef float f32x16 __attribute__((ext_vector_type(16)));
typedef unsigned u32x2 __attribute__((ext_vector_type(2)));
typedef unsigned u32x4 __attribute__((ext_vector_type(4)));

namespace pg8 {
constexpr int BM = 256, BK = 64, HALF = 128, HTB = HALF * BK * 2  , STAGE_BYTES = 8 * HTB, NXCD = 8, WGM = 8;
constexpr int TAG_KEEP = 0x100;

__host__ __device__ __forceinline__ int lds_byte(int r, int c) { const int st = (r >> 4) * 2 + (c >> 5), rr = r & 15, cc = c & 31, ob = rr * 64 + cc * 2; return st * 1024 + (ob ^ (((ob >> 9) & 1) << 5)); }
__host__ __device__ __forceinline__ void stage_rc(int b, int& R, int& C) { const int st = b / 1024, sb = b % 1024, swz = sb ^ (((sb >> 9) & 1) << 5); R = (st >> 1) * 16 + swz / 64; C = (st & 1) * 32 + (swz % 64) / 2; }
__host__ __device__ __forceinline__ int perm32(int rho) { const int n = rho >> 4, i = rho & 15; return 8 * (i >> 2) + 4 * n + (i & 3); }

struct Unit { int pm, pn, nt, tag; const char* A; const char* B; };

__device__ __forceinline__ bool tile_order(int nM, int nN, int G, int c, int i, int& pm, int& pn) {
    const int nwg = nM * nN; const long L = (long)i * G + c; if (L >= nwg) return false;
    int wgid = (int)L; { const int q = nwg / NXCD, r = nwg % NXCD, xcd = wgid % NXCD, off = wgid / NXCD; wgid = (xcd < r ? xcd * (q + 1) : r * (q + 1) + (xcd - r) * q) + off; }
    const int nig = WGM * nN, gid = wgid / nig, fm = gid * WGM, gsz = (nM - fm) < WGM ? (nM - fm) : WGM;
    pm = fm + ((wgid % nig) % gsz); pn = (wgid % nig) / gsz; return true;
}
struct SchedGrid {
    const bf16_t* A; const bf16_t* Bt; int nM, nN, K, G, c, rep;
    __device__ __forceinline__ bool next(int i, Unit& u) const {
        const int my = (nM * nN - c + G - 1) / G;
        if (i >= rep * my) return false;
        (void)tile_order(nM, nN, G, c, i % my, u.pm, u.pn);
        u.nt = K / BK; u.tag = 0; u.A = (const char*)(A + (size_t)u.pm * BM * K); u.B = (const char*)(Bt + (size_t)u.pn * BM * K); return true;
    }
};

__device__ __forceinline__ unsigned cvt_pk_bf16(float lo, float hi) { unsigned r; asm volatile("v_cvt_pk_bf16_f32 %0, %1, %2" : "=v"(r) : "v"(lo), "v"(hi)); return r; }
__device__ __forceinline__ float bf_lo(unsigned w) { return __uint_as_float(w << 16); }
__device__ __forceinline__ float bf_hi(unsigned w) { return __uint_as_float(w & 0xffff0000u); }
__device__ __forceinline__ float sigmoidf_fast(float v) { return __builtin_amdgcn_rcpf(1.0f + __builtin_amdgcn_exp2f(-1.4426950408889634f * v)); }

struct EpiStore {
    static constexpr bool PERM = true;
    bf16_t* O; int ldc; int sig_pn0; bf16_t* O2; int ldc2;
    __device__ __forceinline__ void operator()(f32x4 (&acc)[2][2][4][2], const Unit& u, int wr, int wc, int fr, int fq) const {
        const int row0 = u.pm * BM + wr * 64 + fr, col0 = u.pn * BM + wc * 32 + 8 * fq;
        bf16_t* base = (u.tag & 1) ? O2 : O; const int ld = (u.tag & 1) ? ldc2 : ldc;
        const bool sg = u.pn >= sig_pn0;
#pragma unroll
        for (int ai = 0; ai < 2; ++ai)
#pragma unroll
            for (int m = 0; m < 4; ++m) { bf16_t* rowp = base + (size_t)(row0 + ai * HALF + m * 16) * ld + col0;
#pragma unroll
                for (int bj = 0; bj < 2; ++bj) { f32x4 v0 = acc[ai][bj][m][0], v1 = acc[ai][bj][m][1];
                    if (sg) { v0[0] = sigmoidf_fast(v0[0]); v0[1] = sigmoidf_fast(v0[1]); v0[2] = sigmoidf_fast(v0[2]); v0[3] = sigmoidf_fast(v0[3]);
                              v1[0] = sigmoidf_fast(v1[0]); v1[1] = sigmoidf_fast(v1[1]); v1[2] = sigmoidf_fast(v1[2]); v1[3] = sigmoidf_fast(v1[3]); }
                    u32x4 w; w.x = cvt_pk_bf16(v0[0], v0[1]); w.y = cvt_pk_bf16(v0[2], v0[3]); w.z = cvt_pk_bf16(v1[0], v1[1]); w.w = cvt_pk_bf16(v1[2], v1[3]);
                    *(u32x4*)(rowp + bj * HALF) = w; } }
    }
};
struct EpiBranch {
    static constexpr bool PERM = true;
    const bf16_t* G; int ldg; bf16_t* O; int ldc;
    __device__ __forceinline__ void operator()(f32x4 (&acc)[2][2][4][2], const Unit& u, int wr, int wc, int fr, int fq) const {
        const int seg = u.tag & 3;
        const int row0 = u.pm * BM + wr * 64 + fr, col0 = u.pn * BM + wc * 32 + 8 * fq;
#pragma unroll
        for (int ai = 0; ai < 2; ++ai)
#pragma unroll
            for (int m = 0; m < 4; ++m) { const size_t r = (size_t)(row0 + ai * HALF + m * 16);
#pragma unroll
                for (int bj = 0; bj < 2; ++bj) {
                    const bf16_t* gp = G + r * ldg + col0 + bj * HALF + (seg == 2 ? 4096 : seg == 1 ? 2048 : 0);
                    const u32x4 ga = *(const u32x4*)gp;
                    float f[8];
                    if (seg == 2) { f[0] = bf_lo(ga.x); f[1] = bf_hi(ga.x); f[2] = bf_lo(ga.y); f[3] = bf_hi(ga.y); f[4] = bf_lo(ga.z); f[5] = bf_hi(ga.z); f[6] = bf_lo(ga.w); f[7] = bf_hi(ga.w); }
                    else { const u32x4 gb = *(const u32x4*)(gp + 2048);
                        f[0] = bf_lo(ga.x) * __builtin_amdgcn_rcpf(bf_lo(gb.x)); f[1] = bf_hi(ga.x) * __builtin_amdgcn_rcpf(bf_hi(gb.x));
                        f[2] = bf_lo(ga.y) * __builtin_amdgcn_rcpf(bf_lo(gb.y)); f[3] = bf_hi(ga.y) * __builtin_amdgcn_rcpf(bf_hi(gb.y));
                        f[4] = bf_lo(ga.z) * __builtin_amdgcn_rcpf(bf_lo(gb.z)); f[5] = bf_hi(ga.z) * __builtin_amdgcn_rcpf(bf_hi(gb.z));
                        f[6] = bf_lo(ga.w) * __builtin_amdgcn_rcpf(bf_lo(gb.w)); f[7] = bf_hi(ga.w) * __builtin_amdgcn_rcpf(bf_hi(gb.w)); }
                    f32x4 v0 = acc[ai][bj][m][0], v1 = acc[ai][bj][m][1];
                    v0[0] *= f[0]; v0[1] *= f[1]; v0[2] *= f[2]; v0[3] *= f[3]; v1[0] *= f[4]; v1[1] *= f[5]; v1[2] *= f[6]; v1[3] *= f[7];
                    if (seg == 2) { u32x4 w; w.x = cvt_pk_bf16(v0[0], v0[1]); w.y = cvt_pk_bf16(v0[2], v0[3]); w.z = cvt_pk_bf16(v1[0], v1[1]); w.w = cvt_pk_bf16(v1[2], v1[3]);
                        *(u32x4*)(O + r * ldc + col0 + bj * HALF) = w; }
                    else { acc[ai][bj][m][0] = v0; acc[ai][bj][m][1] = v1; } } }
    }
};

template <class Epi, class Sched>
__device__ __forceinline__ void gemm_phase(LAS unsigned char* lds, const int ldk, const Sched& S, const Epi& E, const int wid  , const int lane  ) {
    const int tid = wid * 64 + lane, wr = wid >> 2, wc = wid & 3, fr = lane & 15, fq = lane >> 4;
    unsigned voffA[2], voffB[2];
#pragma unroll
    for (int i = 0; i < 2; ++i) { int R, C; stage_rc(tid * 16 + i * 8192, R, C); const int Rb = Epi::PERM ? ((R & ~31) + perm32(R & 31)) : R;
        voffA[i] = (unsigned)(R * ldk + C) * 2u; voffB[i] = (unsigned)(Rb * ldk + C) * 2u; }
    const size_t kstep = (size_t)(BK * 2);
    const size_t hstep = (size_t)HALF * ldk * 2;
    const unsigned ldsw = (unsigned)wid * 1024u;
    const int aoff = lds_byte(wr * 64 + fr, fq * 8), boff = lds_byte(wc * 32 + fr, fq * 8);
#define PG8_SA(b, h) (((b) * 2 + (h)) * HTB)
#define PG8_SB(b, h) ((4 + (b) * 2 + (h)) * HTB)
#define PG8_STAGE(bufoff, gbase, voff) do { _Pragma("unroll") for (int _i = 0; _i < 2; ++_i) \
        __builtin_amdgcn_global_load_lds((const unsigned*)((const char*)(gbase) + (voff)[_i]), (LAS unsigned*)(lds + (bufoff) + ldsw + _i * 8192), 16, 0, 0); } while (0)
#define PG8_LDA(dst, b, h) do { _Pragma("unroll") for (int m = 0; m < 4; ++m) _Pragma("unroll") for (int k = 0; k < 2; ++k) dst[m][k] = *(const LAS bf16x8*)(lds + PG8_SA(b, h) + aoff + m * 2048 + k * 1024); } while (0)
#define PG8_LDB(dst, b, h) do { _Pragma("unroll") for (int n = 0; n < 2; ++n) _Pragma("unroll") for (int k = 0; k < 2; ++k) dst[n][k] = *(const LAS bf16x8*)(lds + PG8_SB(b, h) + boff + n * 2048 + k * 1024); } while (0)
#define PG8_MMA(ai, bj, At, Bt) do { __builtin_amdgcn_s_setprio(1); _Pragma("unroll") for (int m = 0; m < 4; ++m) _Pragma("unroll") for (int n = 0; n < 2; ++n) _Pragma("unroll") for (int k = 0; k < 2; ++k) \
        acc[ai][bj][m][n] = __builtin_amdgcn_mfma_f32_16x16x32_bf16(Bt[n][k], At[m][k], acc[ai][bj][m][n], 0, 0, 0); __builtin_amdgcn_s_setprio(0); } while (0)
#define PG8_WAIT_V(n) asm volatile("s_waitcnt vmcnt(" #n ")" ::: "memory")
#define PG8_WAIT_L(n) asm volatile("s_waitcnt lgkmcnt(" #n ")" ::: "memory")
#define PG8_BAR __builtin_amdgcn_s_barrier()
#define PG8_SCHED __builtin_amdgcn_sched_barrier(0)
    Unit cur, nxt; int ui = 0;
    if (!S.next(0, cur)) return;
    f32x4 acc[2][2][4][2];
#pragma unroll
    for (int a = 0; a < 2; ++a)
#pragma unroll
        for (int b = 0; b < 2; ++b)
#pragma unroll
            for (int m = 0; m < 4; ++m)
#pragma unroll
                for (int n = 0; n < 2; ++n) acc[a][b][m][n] = (f32x4){0.f, 0.f, 0.f, 0.f};
    bf16x8 At[4][2], B0[2][2], B1[2][2];
    const char* cA = cur.A; const char* cB = cur.B;
    PG8_STAGE(PG8_SB(0, 0), cB, voffB); PG8_STAGE(PG8_SB(0, 1), cB + hstep, voffB); PG8_STAGE(PG8_SA(0, 0), cA, voffA); PG8_STAGE(PG8_SA(0, 1), cA + hstep, voffA);
    if (wr == 1) PG8_BAR;
    PG8_WAIT_V(2); PG8_BAR;
    PG8_STAGE(PG8_SB(1, 0), cB + kstep, voffB); PG8_STAGE(PG8_SA(1, 0), cA + kstep, voffA); PG8_STAGE(PG8_SB(1, 1), cB + hstep + kstep, voffB);
    PG8_WAIT_V(6); PG8_BAR;
    for (;;) {
        const bool has_next = S.next(ui + 1, nxt);
        const char* nA = has_next ? nxt.A : cA; const char* nB = has_next ? nxt.B : cB;
        const int nt = cur.nt;
        for (int t = 0; t < nt; t += 2) {
            const bool last = (t == nt - 2);
            const char* a1 = cA + (size_t)(t + 1) * kstep;
            const char* a2 = last ? nA : cA + (size_t)(t + 2) * kstep; const char* b2 = last ? nB : cB + (size_t)(t + 2) * kstep;
            const char* a3 = a2 + kstep; const char* b3 = b2 + kstep;
            PG8_LDB(B0, 0, 0); PG8_LDB(B1, 0, 1); PG8_SCHED; PG8_LDA(At, 0, 0); PG8_STAGE(PG8_SA(1, 1), a1 + hstep, voffA);
            PG8_WAIT_V(8); PG8_WAIT_L(0); PG8_BAR; PG8_MMA(0, 0, At, B0); PG8_MMA(0, 1, At, B1); PG8_BAR; PG8_SCHED;
            PG8_LDA(At, 0, 1); PG8_STAGE(PG8_SB(0, 0), b2, voffB); PG8_STAGE(PG8_SB(0, 1), b2 + hstep, voffB); PG8_STAGE(PG8_SA(0, 0), a2, voffA);
            PG8_WAIT_V(8); PG8_WAIT_L(0); PG8_BAR; PG8_MMA(1, 0, At, B0); PG8_MMA(1, 1, At, B1); PG8_BAR; PG8_SCHED;
            PG8_LDB(B0, 1, 0); PG8_LDB(B1, 1, 1); PG8_SCHED; PG8_LDA(At, 1, 0); PG8_STAGE(PG8_SA(0, 1), a2 + hstep, voffA);
            PG8_WAIT_V(8); PG8_WAIT_L(0); PG8_BAR; PG8_MMA(0, 0, At, B0); PG8_MMA(0, 1, At, B1); PG8_BAR; PG8_SCHED;
            PG8_LDA(At, 1, 1); PG8_STAGE(PG8_SB(1, 0), b3, voffB); PG8_STAGE(PG8_SB(1, 1), b3 + hstep, voffB); PG8_STAGE(PG8_SA(1, 0), a3, voffA);
            PG8_WAIT_V(8); PG8_WAIT_L(0); PG8_BAR; PG8_MMA(1, 0, At, B0); PG8_MMA(1, 1, At, B1); PG8_BAR; PG8_SCHED;
        }
        if (wr == 0) PG8_BAR;
        E(acc, cur, wr, wc, fr, fq);
        if (!has_next) break;
        if (!(cur.tag & TAG_KEEP)) {
#pragma unroll
            for (int a = 0; a < 2; ++a)
#pragma unroll
                for (int b = 0; b < 2; ++b)
#pragma unroll
                    for (int m = 0; m < 4; ++m)
#pragma unroll
                        for (int n = 0; n < 2; ++n) acc[a][b][m][n] = (f32x4){0.f, 0.f, 0.f, 0.f};
        }
        cur = nxt; cA = nA; cB = nB; ++ui;
        if (wr == 1) PG8_BAR;
    }
    PG8_WAIT_V(0);
    PG8_BAR;
#undef PG8_SA
#undef PG8_SB
#undef PG8_STAGE
#undef PG8_LDA
#undef PG8_LDB
#undef PG8_MMA
#undef PG8_WAIT_V
#undef PG8_WAIT_L
#undef PG8_BAR
#undef PG8_SCHED
}
}

constexpr int DM = 2048, NBATCH = 4, SEQ = 2048, MROWS = NBATCH * SEQ, DEPTH = 2;
constexpr int CHUNK = 64;
constexpr float EPS = 1e-6f;
constexpr float LOG2E = 1.4426950408889634f;
constexpr int A_HEADS = 8, A_LEFT = 8, A_MAXREL = 128;
constexpr int B_HEADS = 8, B_LAT = 128, IDX_HEADS = 8, IDX_DIM = 64, TOPK = 256;
constexpr int C_QH = 16, C_LEFT = 2;
constexpr int MEM_LEN = 256, MEM_HEADS = 4, MEM_HD = 128, MEM_W = 512;
constexpr int DFF = 5504;
constexpr int IN_W = 10184;
constexpr int LDP = 10240;
constexpr int O_QA = 0, O_KA = 512, O_VA = 1024, O_QB = 1536, O_CKV = 2048, O_QI = 2176, O_KI = 2688, O_WI = 2752, O_QC = 2760, O_KC = 3784, O_VC = 3912, O_GLREAL = 4040, O_GL = 4096;
constexpr int NT5 = 24;
constexpr int NWAVES = 8;

constexpr size_t al256(size_t x) { return (x + 255) & ~(size_t)255; }
constexpr size_t WS_CTL = 0, CTL_ZERO_BYTES = 1u << 20;
constexpr size_t WS_WUK = CTL_ZERO_BYTES;
constexpr size_t WS_WUVT = WS_WUK + (size_t)DEPTH * 8 * 128 * 64 * 2;
constexpr size_t WS_MEMN = WS_WUVT + (size_t)DEPTH * 8 * 128 * 64 * 2;
constexpr size_t WS_KVM = WS_MEMN + (size_t)DEPTH * 1024 * DM * 2;
constexpr size_t WS_CKVN = WS_KVM + (size_t)DEPTH * 1024 * 1024 * 2;
constexpr size_t WS_MASK = WS_CKVN + (size_t)MROWS * B_LAT * 2;
constexpr size_t WS_W0 = WS_MASK + (size_t)MROWS * 64 * 4;
constexpr size_t WL_IN = 0;
constexpr size_t WL_BR = WL_IN + (size_t)LDP * DM * 2;
constexpr size_t WL_O = WL_BR + (size_t)DM * DM * 2;
constexpr size_t WL_MQ = WL_O + (size_t)DM * DM * 2;
constexpr size_t WL_MKV = WL_MQ + (size_t)MEM_W * DM * 2;
constexpr size_t WL_MO = WL_MKV + (size_t)2 * MEM_W * DM * 2;
constexpr size_t WL_UP = WL_MO + (size_t)DM * MEM_W * 2;
constexpr size_t WL_DN = WL_UP + (size_t)2 * DFF * DM * 2;
constexpr size_t WL_SIZE = WL_DN + (size_t)DM * DFF * 2;
constexpr size_t WS_H = WS_W0 + DEPTH * WL_SIZE;
constexpr size_t WS_BIG = WS_H + (size_t)MROWS * DM * 2;
constexpr size_t WS_CAT = WS_BIG + (size_t)MROWS * 2 * DFF * 2;
constexpr size_t WS_MRG = WS_CAT + (size_t)MROWS * DM * 2;
constexpr size_t WS_Y = WS_MRG + (size_t)MROWS * DM * 2;
constexpr size_t WS_ACT = WS_Y + (size_t)MROWS * DM * 2;
constexpr size_t WS_END = WS_ACT + (size_t)MROWS * DFF * 2;
static_assert(WS_W0 % 256 == 0 && WL_SIZE % 256 == 0 && WS_H % 256 == 0 && WS_ACT % 256 == 0, "alignment");
constexpr int CW_BAR = 4096;

constexpr int RING_BYTES = 131072;
constexpr int LDSCTL_OFF = RING_BYTES, MISC_OFF = LDSCTL_OFF + 320;
constexpr int LDS_BYTES = 147456;
constexpr int WAVE_LDS = 16384;

#define XB_TMO      128
#define XB_XCNT(j)  (256  + 64 * (j))
#define XB_XSUB(j)  (1280 + 64 * (j))
#define XB_XGEN(j)  (2304 + 64 * (j))
#define XB_TOP      3328
#define XB_TOPGEN   3392
#define XCD_BAR_WORDS 3456
#define XB_SPIN_CAP (1u << 18)
__device__ __forceinline__ unsigned xb_ld(unsigned* p)              { return __hip_atomic_load(p, __ATOMIC_RELAXED, __HIP_MEMORY_SCOPE_AGENT); }
__device__ __forceinline__ unsigned xb_add(unsigned* p, unsigned v) { return __hip_atomic_fetch_add(p, v, __ATOMIC_RELAXED, __HIP_MEMORY_SCOPE_AGENT); }
__device__ __forceinline__ unsigned xb_xcc_id() { return (unsigned)__builtin_amdgcn_s_getreg((3 << 11) | 20) & 0xFu; }
#define XB_SPIN(cond, bar) do { unsigned _sp = 0; while (cond) { __builtin_amdgcn_s_sleep(1); \
    if ((++_sp & 255u) == 0u) { if (xb_ld(&(bar)[XB_TMO])) break; if (_sp > XB_SPIN_CAP) { atomicAdd(&(bar)[XB_TMO], 1u); break; } } } } while (0)
struct XcdBarrier { unsigned* bar; unsigned x; volatile LAS unsigned* st; };
__device__ __forceinline__ XcdBarrier xcd_barrier_post(unsigned* bar, volatile LAS unsigned* st) {
    XcdBarrier b; b.bar = bar; b.x = xb_xcc_id(); b.st = st;
    if (threadIdx.x == 0) (void)xb_add(&bar[XB_XCNT(b.x)], 1u);
    return b;
}
__device__ __forceinline__ void xcd_barrier_complete(unsigned* bar, unsigned x, unsigned& nloc, unsigned& nx) {
    const unsigned G = gridDim.x * gridDim.y * gridDim.z;
    unsigned sum, cnt, mine, sp = 0u;
    for (;;) {
        sum = 0u; cnt = 0u; mine = 0u;
#pragma unroll
        for (unsigned j = 0; j < 16; ++j) { const unsigned c = xb_ld(&bar[XB_XCNT(j)]); sum += c; cnt += (c > 0u) ? 1u : 0u; mine = (j == x) ? c : mine; }
        if (sum == G) break;
        __builtin_amdgcn_s_sleep(1);
        if ((++sp & 255u) == 0u) { if (xb_ld(&bar[XB_TMO])) break; if (sp > XB_SPIN_CAP) { atomicAdd(&bar[XB_TMO], 1u); break; } }
    }
    nloc = mine > 0u ? mine : 1u; nx = cnt > 0u ? cnt : 1u;
}
__device__ __forceinline__ void xcd_barrier(const XcdBarrier& b, const bool leader  ) {
    asm volatile("s_waitcnt vmcnt(0)" ::: "memory");
    __syncthreads();
    if (leader) {
        unsigned* bar = b.bar;
        __builtin_amdgcn_s_waitcnt(0);
        unsigned nloc = b.st[0], nx = b.st[1];
        if (nloc == 0u) { xcd_barrier_complete(bar, b.x, nloc, nx); b.st[0] = nloc; b.st[1] = nx; }
        const unsigned old = xb_add(&bar[XB_XSUB(b.x)], 1u);
        const unsigned gen = old / nloc;
        if (old + 1u == (gen + 1u) * nloc) {
            __builtin_amdgcn_fence(__ATOMIC_RELEASE, "agent");
            asm volatile("s_waitcnt vmcnt(0)" ::: "memory");
            const unsigned og = xb_add(&bar[XB_TOP], 1u);
            const unsigned tg = og / nx;
            if (og + 1u == (tg + 1u) * nx) xb_add(&bar[XB_TOPGEN], 1u);
            else XB_SPIN(xb_ld(&bar[XB_TOPGEN]) == tg, bar);
            __builtin_amdgcn_fence(__ATOMIC_ACQUIRE, "agent");
            xb_add(&bar[XB_XGEN(b.x)], 1u);
            asm volatile("s_waitcnt vmcnt(0)" ::: "memory");
        } else {
            XB_SPIN(xb_ld(&bar[XB_XGEN(b.x)]) == gen, bar);
            __builtin_amdgcn_fence(__ATOMIC_ACQUIRE, "agent");
            asm volatile("s_waitcnt vmcnt(0)" ::: "memory");
        }
    }
    __syncthreads();
}

__device__ __forceinline__ int fresh_lane() { int l; asm volatile("v_mbcnt_lo_u32_b32 %0, -1, 0\n\tv_mbcnt_hi_u32_b32 %0, -1, %0" : "=v"(l)); return l; }
#define LDS_WAIT() asm volatile("s_waitcnt lgkmcnt(0)" ::: "memory")
__device__ __forceinline__ unsigned f2bf(float f) { unsigned u = __builtin_bit_cast(unsigned, f); return (u + 0x7fffu + ((u >> 16) & 1u)) >> 16; }
__device__ __forceinline__ unsigned pk2(float lo, float hi) { return f2bf(lo) | (f2bf(hi) << 16); }
__device__ __forceinline__ float bfl(unsigned w) { return __uint_as_float(w << 16); }
__device__ __forceinline__ float bfh(unsigned w) { return __uint_as_float(w & 0xffff0000u); }
__device__ __forceinline__ float swz_xor(float v, int k) {
    switch (k) {
        case 1: return __int_as_float(__builtin_amdgcn_ds_swizzle(__float_as_int(v), 0x1F | (1 << 10)));
        case 2: return __int_as_float(__builtin_amdgcn_ds_swizzle(__float_as_int(v), 0x1F | (2 << 10)));
        case 4: return __int_as_float(__builtin_amdgcn_ds_swizzle(__float_as_int(v), 0x1F | (4 << 10)));
        case 8: return __int_as_float(__builtin_amdgcn_ds_swizzle(__float_as_int(v), 0x1F | (8 << 10)));
        default: return __int_as_float(__builtin_amdgcn_ds_swizzle(__float_as_int(v), 0x1F | (16 << 10)));
    }
}
__device__ __forceinline__ float xor32_sum(float v) { auto rr = __builtin_amdgcn_permlane32_swap(__float_as_uint(v), __float_as_uint(v), false, false); return __uint_as_float(rr[0]) + __uint_as_float(rr[1]); }
__device__ __forceinline__ float xor32_max(float v) { auto rr = __builtin_amdgcn_permlane32_swap(__float_as_uint(v), __float_as_uint(v), false, false); return fmaxf(__uint_as_float(rr[0]), __uint_as_float(rr[1])); }
__device__ __forceinline__ float wave_sum(float v) {
    v += swz_xor(v, 1); v += swz_xor(v, 2); v += swz_xor(v, 4); v += swz_xor(v, 8); v += swz_xor(v, 16);
    return xor32_sum(v);
}
__device__ __forceinline__ int t5_bucket(int rel) {
    const int d = rel < 0 ? -rel : rel;
    const int b = d < 8 ? d : d < 13 ? 8 : d < 20 ? 9 : d < 30 ? 10 : d < 46 ? 11 : d < 70 ? 12 : d < 108 ? 13 : d < 166 ? 14 : 15;
    return b + (rel > 0 ? 16 : 0);
}

struct Params {
    const float *x, *mem, *t5, *gains, *w_in, *a_rel, *ckv_gain, *w_uk, *w_uv, *sinks, *w_branch, *w_o, *mem_gain, *w_mq, *w_mkv, *w_mo, *w_up, *conv_w, *conv_b, *w_down;
    float* out; unsigned char* ws;
};
struct Frame { LAS unsigned char* lds; int tid, lane, wave, vcu, G, gw, NGW; };

struct CsId { __device__ __forceinline__ int operator()(int n) const { return n; } };
struct CsIn { __device__ __forceinline__ int operator()(int n) const { return n < O_GLREAL ? n : n < O_GL ? -1 : n - (O_GL - O_GLREAL); } };
template <class CSrc>
__device__ __forceinline__ void tr_load(const float* W, int N, int k0, int n0, int lane, const CSrc& csrc, f32x4 (&v)[16]) {
    const int cs = csrc(n0 + 4 * (lane & 15));
    const float* p = W + (size_t)(k0 + (lane >> 4)) * N + (cs < 0 ? 0 : cs);
#pragma unroll
    for (int i = 0; i < 16; ++i) { v[i] = *(const f32x4*)(p + (size_t)(4 * i) * N); if (cs < 0) v[i] = (f32x4){0.f, 0.f, 0.f, 0.f}; }
}
__device__ __forceinline__ void tr_store(bf16_t* WT, int K, int k0, int n0, int lane, LAS unsigned char* scr, const f32x4 (&v)[16]) {
    constexpr int STR = 136;
#pragma unroll
    for (int i = 0; i < 16; ++i) { u32x2 w; w.x = pg8::cvt_pk_bf16(v[i].x, v[i].y); w.y = pg8::cvt_pk_bf16(v[i].z, v[i].w);
        *(LAS u32x2*)(scr + (4 * i + (lane >> 4)) * STR + (lane & 15) * 8) = w; }
    asm volatile("s_waitcnt lgkmcnt(0)" ::: "memory");
    const int g = lane >> 4, q = (lane & 15) >> 2, pp = lane & 3;
#pragma unroll
    for (int j = 0; j < 2; ++j)
#pragma unroll
        for (int nb = 0; nb < 4; ++nb) {
            const int kbase = 8 * (4 * j + g);
            const LAS unsigned char* a = scr + (kbase + q) * STR + (16 * nb + 4 * pp) * 2;
            const s16x4 lo = __builtin_bit_cast(s16x4, __builtin_amdgcn_ds_read_tr16_b64_v4i16((LAS s16x4*)a));
            const s16x4 hi = __builtin_bit_cast(s16x4, __builtin_amdgcn_ds_read_tr16_b64_v4i16((LAS s16x4*)(a + 4 * STR)));
            const bf16x8 o = (bf16x8){lo[0], lo[1], lo[2], lo[3], hi[0], hi[1], hi[2], hi[3]};
            *(bf16x8*)(WT + (size_t)(n0 + 16 * nb + (lane & 15)) * K + k0 + kbase) = o;
        }
    asm volatile("s_waitcnt lgkmcnt(0)" ::: "memory");
}

__device__ __forceinline__ void rms_row_to_bf16(const float* xrow, const float* g, bf16_t* orow, int lane) {
    const f32x4* xr = (const f32x4*)xrow + lane;
    f32x4 v[8]; float s = 0.f;
#pragma unroll
    for (int j = 0; j < 8; ++j) { v[j] = xr[64 * j]; s += (v[j].x * v[j].x + v[j].y * v[j].y) + (v[j].z * v[j].z + v[j].w * v[j].w); }
    const float r = 1.0f / sqrtf(wave_sum(s) * (1.0f / DM) + EPS);
    const f32x4* gr = (const f32x4*)g + lane;
    u32x2* o8 = (u32x2*)orow + lane;
#pragma unroll
    for (int j = 0; j < 8; ++j) { const f32x4 gg = gr[64 * j]; u32x2 w; w.x = pk2(v[j].x * r * gg.x, v[j].y * r * gg.y); w.y = pk2(v[j].z * r * gg.z, v[j].w * r * gg.w); o8[64 * j] = w; }
}
__device__ __forceinline__ void resnorm_row(const float* xin, const bf16_t* y, const float* g1, float* xout, const float* g2, bf16_t* hout, int lane) {
    const u32x2* yr = (const u32x2*)y + lane;
    f32x4 v[8]; float s = 0.f;
#pragma unroll
    for (int j = 0; j < 8; ++j) { const u32x2 w = yr[64 * j]; v[j] = (f32x4){bfl(w.x), bfh(w.x), bfl(w.y), bfh(w.y)}; s += (v[j].x * v[j].x + v[j].y * v[j].y) + (v[j].z * v[j].z + v[j].w * v[j].w); }
    const float r = 1.0f / sqrtf(wave_sum(s) * (1.0f / DM) + EPS);
    const f32x4* gr = (const f32x4*)g1 + lane; const f32x4* xr = (const f32x4*)xin + lane; f32x4* xo = (f32x4*)xout + lane;
    float s2 = 0.f;
#pragma unroll
    for (int j = 0; j < 8; ++j) { const f32x4 gg = gr[64 * j]; const f32x4 xx = xr[64 * j];
        v[j] = (f32x4){xx.x + v[j].x * r * gg.x, xx.y + v[j].y * r * gg.y, xx.z + v[j].z * r * gg.z, xx.w + v[j].w * r * gg.w};
        xo[64 * j] = v[j]; s2 += (v[j].x * v[j].x + v[j].y * v[j].y) + (v[j].z * v[j].z + v[j].w * v[j].w); }
    if (hout) {
        const float r2 = 1.0f / sqrtf(wave_sum(s2) * (1.0f / DM) + EPS);
        const f32x4* hr = (const f32x4*)g2 + lane; u32x2* o8 = (u32x2*)hout + lane;
#pragma unroll
        for (int j = 0; j < 8; ++j) { const f32x4 gg = hr[64 * j]; u32x2 w; w.x = pk2(v[j].x * r2 * gg.x, v[j].y * r2 * gg.y); w.y = pk2(v[j].z * r2 * gg.z, v[j].w * r2 * gg.w); o8[64 * j] = w; }
    }
}

__device__ __forceinline__ int pi32(int r) { return (r & ~12) | ((r & 4) << 1) | ((r & 8) >> 1); }
__device__ __forceinline__ int koff(int r, int hh) { return (r & 7) + 8 * hh + 16 * (r >> 3); }
__device__ __forceinline__ int crow(int r, int hh) { return (r & 3) + 8 * (r >> 2) + 4 * hh; }
__device__ __forceinline__ bf16x8 pack8(float a0, float a1, float a2, float a3, float a4, float a5, float a6, float a7) {
    u32x4 w; w.x = pg8::cvt_pk_bf16(a0, a1); w.y = pg8::cvt_pk_bf16(a2, a3); w.z = pg8::cvt_pk_bf16(a4, a5); w.w = pg8::cvt_pk_bf16(a6, a7);
    return __builtin_bit_cast(bf16x8, w);
}
typedef short v4i16_t __attribute__((ext_vector_type(4)));
__device__ __forceinline__ s16x4 vtr(const LAS unsigned char* p) { return __builtin_bit_cast(s16x4, __builtin_amdgcn_ds_read_tr16_b64_v4i16((LAS v4i16_t*)p)); }
#define MFMA32(a, b, c) __builtin_amdgcn_mfma_f32_32x32x16_bf16((a), (b), (c), 0, 0, 0)

template <int D> struct AttnCore {
    static constexpr int NQ = D / 16, NB = D / 32, VSTR = D * 2 + 16, NV = D / 16;
    f32x16 o[NB]; float m, l;
    __device__ __forceinline__ void init() {
#pragma unroll
        for (int b = 0; b < NB; ++b)
#pragma unroll
            for (int r = 0; r < 16; ++r) o[b][r] = 0.f;
        m = -1e30f; l = 0.f; }
    __device__ __forceinline__ void load_v(const bf16_t* vp, size_t ldv, int lane, u32x4 (&st)[NV]) const {
#pragma unroll
        for (int i = 0; i < NV; ++i) { const int idx = lane + 64 * i, row = idx / (D / 8), ch = idx % (D / 8); st[i] = *(const u32x4*)(vp + (size_t)row * ldv + ch * 8); }
    }
    __device__ __forceinline__ void write_v(LAS unsigned char* vb, int lane, const u32x4 (&st)[NV]) const {
#pragma unroll
        for (int i = 0; i < NV; ++i) { const int idx = lane + 64 * i, row = idx / (D / 8), ch = idx % (D / 8); *(LAS u32x4*)(vb + row * VSTR + ch * 16) = st[i]; }
    }
    __device__ __forceinline__ void softmax(f32x16& S, bf16x8& p0, bf16x8& p1) {
        float mx = fmaxf(fmaxf(S[0], S[1]), fmaxf(S[2], S[3]));
#pragma unroll
        for (int r = 4; r < 16; r += 4) mx = fmaxf(mx, fmaxf(fmaxf(S[r], S[r + 1]), fmaxf(S[r + 2], S[r + 3])));
        mx = xor32_max(mx);
        if (__any(mx > m)) {
            const float mn = fmaxf(m, mx), f = __builtin_amdgcn_exp2f(m - mn);
            l *= f;
#pragma unroll
            for (int b = 0; b < NB; ++b) o[b] = o[b] * f;
            m = mn;
        }
        float ls = 0.f;
#pragma unroll
        for (int r = 0; r < 16; ++r) { S[r] = __builtin_amdgcn_exp2f(S[r] - m); ls += S[r]; }
        l += ls;
        p0 = pack8(S[0], S[1], S[2], S[3], S[4], S[5], S[6], S[7]);
        p1 = pack8(S[8], S[9], S[10], S[11], S[12], S[13], S[14], S[15]);
    }
    __device__ __forceinline__ void pv(const LAS unsigned char* vb, int lane, bf16x8 p0, bf16x8 p1) {
        const int hh = lane >> 5, blk = (lane >> 4) & 1, q = (lane & 15) >> 2, p = lane & 3;
        const LAS unsigned char* base = vb + (8 * hh + q) * VSTR + (16 * blk + 4 * p) * 2;
#pragma unroll
        for (int b = 0; b < NB; ++b)
#pragma unroll
            for (int s = 0; s < 2; ++s) {
                const s16x4 lo = vtr(base + (16 * s) * VSTR + 64 * b), hi = vtr(base + (16 * s + 4) * VSTR + 64 * b);
                const bf16x8 a = (bf16x8){lo[0], lo[1], lo[2], lo[3], hi[0], hi[1], hi[2], hi[3]};
                o[b] = MFMA32(a, s ? p1 : p0, o[b]);
            }
    }
    __device__ __forceinline__ float lsum() const { return xor32_sum(l); }
};


__device__ __forceinline__ int sw128(int row) { return ((row & 3) << 2) | ((row >> 2) & 3); }
__device__ __forceinline__ int off128(int row, int ch) { return 256 * row + 16 * (ch ^ sw128(row)); }
struct AttnCore128 {
    static constexpr int NB = 4, TILE = 8192;
    f32x16 o[NB]; float m, l;
    __device__ __forceinline__ void init() {
#pragma unroll
        for (int b = 0; b < NB; ++b)
#pragma unroll
            for (int r = 0; r < 16; ++r) o[b][r] = 0.f;
        m = -1e30f; l = 0.f; }
    __device__ __forceinline__ void dma(const bf16_t* vp, unsigned ldv, int lane_, LAS unsigned char* buf) const {
        int lane = lane_; asm volatile("" : "+v"(lane));
        const unsigned rl = (unsigned)lane >> 4, cl = (unsigned)lane & 15u;
#pragma unroll
        for (int i = 0; i < 8; ++i) { const unsigned row = 4u * i + rl, ch = cl ^ ((rl << 2) | (unsigned)(i & 3));
            const unsigned voff = (row * ldv + ch * 8u) * 2u;
            __builtin_amdgcn_global_load_lds((const unsigned*)((const char*)vp + voff), (LAS unsigned*)(buf + 1024 * i), 16, 0, 0); }
    }
    __device__ __forceinline__ void softmax(f32x16& S, bf16x8& p0, bf16x8& p1) {
        float mx = fmaxf(fmaxf(S[0], S[1]), fmaxf(S[2], S[3]));
#pragma unroll
        for (int r = 4; r < 16; r += 4) mx = fmaxf(mx, fmaxf(fmaxf(S[r], S[r + 1]), fmaxf(S[r + 2], S[r + 3])));
        mx = xor32_max(mx);
        if (__any(mx > m)) {
            const float mn = fmaxf(m, mx), f = __builtin_amdgcn_exp2f(m - mn);
            l *= f;
#pragma unroll
            for (int b = 0; b < NB; ++b) o[b] = o[b] * f;
            m = mn;
        }
        float ls = 0.f;
#pragma unroll
        for (int r = 0; r < 16; ++r) { S[r] = __builtin_amdgcn_exp2f(S[r] - m); ls += S[r]; }
        l += ls;
        p0 = pack8(S[0], S[1], S[2], S[3], S[4], S[5], S[6], S[7]);
        p1 = pack8(S[8], S[9], S[10], S[11], S[12], S[13], S[14], S[15]);
    }
    __device__ __forceinline__ void pv(const LAS unsigned char* buf, int lane, bf16x8 p0, bf16x8 p1) {
        const int hh = lane >> 5, blk = (lane >> 4) & 1, q = (lane & 15) >> 2, p = lane & 3;
#pragma unroll
        for (int b = 0; b < NB; ++b)
#pragma unroll
            for (int s = 0; s < 2; ++s) {
                const s16x4 lo = vtr(buf + off128(16 * s + 8 * hh + q, 4 * b + 2 * blk + (p >> 1)) + 8 * (p & 1));
                const s16x4 hi = vtr(buf + off128(16 * s + 8 * hh + 4 + q, 4 * b + 2 * blk + (p >> 1)) + 8 * (p & 1));
                const bf16x8 a = (bf16x8){lo[0], lo[1], lo[2], lo[3], hi[0], hi[1], hi[2], hi[3]};
                o[b] = MFMA32(a, s ? p1 : p0, o[b]);
            }
    }
    __device__ __forceinline__ float lsum() const { return xor32_sum(l); }
};

template <int NQ> __device__ __forceinline__ void load_kfrags(const bf16_t* kp, size_t ldk, int lane, bf16x8 (&kf)[NQ]) {
    const bf16_t* rp = kp + (size_t)pi32(lane & 31) * ldk + 8 * (lane >> 5);
#pragma unroll
    for (int kk = 0; kk < NQ; ++kk) kf[kk] = *(const bf16x8*)(rp + 16 * kk);
}
template <int NQ> __device__ __forceinline__ void load_qfrags(const bf16_t* qp, size_t ldq, int lane, bf16x8 (&qf)[NQ]) {
    const bf16_t* rp = qp + (size_t)(lane & 31) * ldq + 8 * (lane >> 5);
#pragma unroll
    for (int kk = 0; kk < NQ; ++kk) qf[kk] = *(const bf16x8*)(rp + 16 * kk);
}
template <int NB> __device__ __forceinline__ void store_ot(const f32x16 (&o)[NB], float inv, bf16_t* op  , size_t ldo, int lane) {
    const int hh = lane >> 5; bf16_t* rp = op + (size_t)(lane & 31) * ldo + 4 * hh;
#pragma unroll
    for (int b = 0; b < NB; ++b)
#pragma unroll
        for (int g = 0; g < 4; ++g) { u32x2 w; w.x = pg8::cvt_pk_bf16(o[b][4 * g] * inv, o[b][4 * g + 1] * inv); w.y = pg8::cvt_pk_bf16(o[b][4 * g + 2] * inv, o[b][4 * g + 3] * inv);
            *(u32x2*)(rp + 32 * b + 8 * g) = w; }
}

__device__ __forceinline__ void attn_a_item(const bf16_t* P, const float* relb, bf16_t* cat, int item, int lane, LAS unsigned char* wl) {
    const int qh = item & 1, h = (item >> 1) & 7, c = (item >> 4) & 31, b = item >> 9;
    const int qpos0 = c * CHUNK + 32 * qh; const size_t q0 = (size_t)b * SEQ + qpos0;
    LAS float* tab = (LAS float*)(wl + 9216);
    for (int i = lane; i < 2 * A_MAXREL + 1; i += 64) tab[i] = relb[i * A_HEADS + h] * LOG2E;
    bf16x8 qf[4]; load_qfrags<4>(P + q0 * LDP + O_QA + h * 64, LDP, lane, qf);
    const bf16_t* Kp = P + (size_t)b * SEQ * LDP + O_KA + h * 64; const bf16_t* Vp = P + (size_t)b * SEQ * LDP + O_VA + h * 64;
    const int kbeg = (c - A_LEFT < 0 ? 0 : c - A_LEFT) * CHUNK, kend = (c + 1) * CHUNK;
    AttnCore<64> core; core.init();
    bf16x8 kf[4]; u32x4 vst[4];
    load_kfrags<4>(Kp + (size_t)kbeg * LDP, LDP, lane, kf);
    core.load_v(Vp + (size_t)kbeg * LDP, LDP, lane, vst);
    LDS_WAIT();
    core.write_v(wl, lane, vst);
    const int hh = lane >> 5, qpos = qpos0 + (lane & 31);
    const float SC = 0.125f * LOG2E;
    for (int kb = kbeg; kb < kend; kb += 32) {
        const bool has_next = kb + 32 < kend;
        f32x16 S;
#pragma unroll
        for (int r = 0; r < 16; ++r) S[r] = 0.f;
#pragma unroll
        for (int kk = 0; kk < 4; ++kk) S = MFMA32(kf[kk], qf[kk], S);
        if (has_next) { load_kfrags<4>(Kp + (size_t)(kb + 32) * LDP, LDP, lane, kf); core.load_v(Vp + (size_t)(kb + 32) * LDP, LDP, lane, vst); }
        if (kb + 31 + A_MAXREL <= qpos0) {
            const float bc = tab[2 * A_MAXREL];
#pragma unroll
            for (int r = 0; r < 16; ++r) S[r] = S[r] * SC + bc;
        } else {
#pragma unroll
            for (int r = 0; r < 16; ++r) { int rel = qpos - (kb + koff(r, hh)); rel = rel > A_MAXREL ? A_MAXREL : rel; S[r] = S[r] * SC + tab[rel + A_MAXREL]; }
        }
        bf16x8 p0, p1; core.softmax(S, p0, p1);
        core.pv(wl, lane, p0, p1);
        asm volatile("" ::: "memory");
        if (has_next) core.write_v(wl, lane, vst);
        asm volatile("" ::: "memory");
    }
    store_ot<2>(core.o, 1.0f / core.lsum(), cat + q0 * DM + h * 64, DM, lane);
    LDS_WAIT();
}

__device__ __forceinline__ void attn_c_item(const bf16_t* P, const float* t5, const float* sinks, bf16_t* cat, int item, int lane, LAS unsigned char* wl) {
    const int qh = item & 1, hq = (item >> 1) & 15, c = (item >> 5) & 31, b = item >> 10;
    const int kvh = hq >> 3;
    const int qpos0 = c * CHUNK + 32 * qh; const size_t q0 = (size_t)b * SEQ + qpos0;
    LAS float* tab = (LAS float*)(wl + 9216);
    for (int i = lane; i < 255; i += 64) tab[i] = t5[t5_bucket(i - 191) * NT5 + B_HEADS + hq] * LOG2E;
    bf16x8 qf[4]; load_qfrags<4>(P + q0 * LDP + O_QC + hq * 64, LDP, lane, qf);
    const bf16_t* Kp = P + (size_t)b * SEQ * LDP + O_KC + kvh * 64; const bf16_t* Vp = P + (size_t)b * SEQ * LDP + O_VC + kvh * 64;
    const int kbeg = (c - C_LEFT < 0 ? 0 : c - C_LEFT) * CHUNK, kend = (c + 1) * CHUNK;
    AttnCore<64> core; core.init();
    bf16x8 kf[4]; u32x4 vst[4];
    load_kfrags<4>(Kp + (size_t)kbeg * LDP, LDP, lane, kf);
    core.load_v(Vp + (size_t)kbeg * LDP, LDP, lane, vst);
    LDS_WAIT();
    core.write_v(wl, lane, vst);
    const int hh = lane >> 5, qpos = qpos0 + (lane & 31);
    const float SC = 0.125f * LOG2E;
    for (int kb = kbeg; kb < kend; kb += 32) {
        const bool has_next = kb + 32 < kend;
        f32x16 S;
#pragma unroll
        for (int r = 0; r < 16; ++r) S[r] = 0.f;
#pragma unroll
        for (int kk = 0; kk < 4; ++kk) S = MFMA32(kf[kk], qf[kk], S);
        if (has_next) { load_kfrags<4>(Kp + (size_t)(kb + 32) * LDP, LDP, lane, kf); core.load_v(Vp + (size_t)(kb + 32) * LDP, LDP, lane, vst); }
#pragma unroll
        for (int r = 0; r < 16; ++r) { const int rel = (kb + koff(r, hh)) - qpos; S[r] = S[r] * SC + tab[rel + 191]; }
        bf16x8 p0, p1; core.softmax(S, p0, p1);
        core.pv(wl, lane, p0, p1);
        asm volatile("" ::: "memory");
        if (has_next) core.write_v(wl, lane, vst);
        asm volatile("" ::: "memory");
    }
    const float sk = sinks[hq] * LOG2E, lt = core.lsum();
    const float m2 = fmaxf(core.m, sk), e1 = __builtin_amdgcn_exp2f(core.m - m2), e2 = __builtin_amdgcn_exp2f(sk - m2);
    store_ot<2>(core.o, e1 / (lt * e1 + e2), cat + q0 * DM + 1024 + hq * 64, DM, lane);
    LDS_WAIT();
}

__device__ __forceinline__ void attn_mem_item(const bf16_t* qm, const bf16_t* kvm, bf16_t* om, int item, int lane, LAS unsigned char* wl) {
    const int h = item & 3, j = (item >> 2) & 63, b = item >> 8;
    const size_t q0 = (size_t)b * SEQ + 32 * j;
    bf16x8 qf[8]; load_qfrags<8>(qm + q0 * MEM_W + h * MEM_HD, MEM_W, lane, qf);
    const bf16_t* Kp = kvm + (size_t)b * MEM_LEN * (2 * MEM_W) + h * MEM_HD; const bf16_t* Vp = Kp + MEM_W;
    AttnCore128 core; core.init();
    bf16x8 kf[8];
    LDS_WAIT();
    core.dma(Vp, 2 * MEM_W, lane, wl);
    load_kfrags<8>(Kp, 2 * MEM_W, lane, kf);
    const float SC = 0.08838834764831845f * LOG2E;
#pragma unroll 1
    for (int kb = 0; kb < MEM_LEN; kb += 32) {
        const bool has_next = kb + 32 < MEM_LEN;
        LAS unsigned char* buf = wl + ((kb >> 5) & 1) * AttnCore128::TILE;
        asm volatile("s_waitcnt vmcnt(0)" ::: "memory");
        if (has_next) core.dma(Vp + (size_t)(kb + 32) * (2 * MEM_W), 2 * MEM_W, lane, wl + (((kb >> 5) + 1) & 1) * AttnCore128::TILE);
        f32x16 S;
#pragma unroll
        for (int r = 0; r < 16; ++r) S[r] = 0.f;
#pragma unroll
        for (int kk = 0; kk < 8; ++kk) S = MFMA32(kf[kk], qf[kk], S);
        if (has_next) load_kfrags<8>(Kp + (size_t)(kb + 32) * (2 * MEM_W), 2 * MEM_W, lane, kf);
#pragma unroll
        for (int r = 0; r < 16; ++r) S[r] = S[r] * SC;
        bf16x8 p0, p1; core.softmax(S, p0, p1);
        core.pv(buf, lane, p0, p1);
        asm volatile("" ::: "memory");
    }
    store_ot<4>(core.o, 1.0f / core.lsum(), om + q0 * MEM_W + h * MEM_HD, MEM_W, lane);
    LDS_WAIT();
}

__device__ __forceinline__ void idx_score_item(const bf16_t* P, float* score, int item, int lane) {
    const int qh = item & 1; int i2 = item >> 1; const int b = i2 / 528, p = i2 % 528, a = p / 33, k = p % 33;
    int c, kc; if (k <= a + 16) { c = a + 16; kc = k; } else { c = 15 - a; kc = k - a - 17; }
    const size_t q0 = (size_t)b * SEQ + c * CHUNK + 32 * qh, k0 = (size_t)b * SEQ + kc * CHUNK;
    const int r32 = lane & 31, hh = lane >> 5;
    bf16x8 kf[2][4];
#pragma unroll
    for (int t = 0; t < 2; ++t)
#pragma unroll
        for (int kk = 0; kk < 4; ++kk) kf[t][kk] = *(const bf16x8*)(P + (k0 + 32 * t + r32) * LDP + O_KI + 16 * kk + 8 * hh);
    f32x16 sc[2];
#pragma unroll
    for (int t = 0; t < 2; ++t)
#pragma unroll
        for (int r = 0; r < 16; ++r) sc[t][r] = 0.f;
    const bf16_t* qrow = P + (q0 + r32) * LDP;
#pragma unroll 1
    for (int hd = 0; hd < IDX_HEADS; ++hd) {
        bf16x8 qf[4];
#pragma unroll
        for (int kk = 0; kk < 4; ++kk) qf[kk] = *(const bf16x8*)(qrow + O_QI + hd * 64 + 16 * kk + 8 * hh);
        const float w = __uint_as_float((unsigned)qrow[O_WI + hd] << 16) * (0.125f * 0.35355339059327373f);
#pragma unroll
        for (int t = 0; t < 2; ++t) {
            f32x16 S;
#pragma unroll
            for (int r = 0; r < 16; ++r) S[r] = 0.f;
#pragma unroll
            for (int kk = 0; kk < 4; ++kk) S = MFMA32(kf[t][kk], qf[kk], S);
#pragma unroll
            for (int r = 0; r < 16; ++r) sc[t][r] += fmaxf(S[r], 0.f) * w;
        }
    }
    float* srow = score + (q0 + r32) * SEQ + kc * CHUNK + 4 * hh;
#pragma unroll
    for (int t = 0; t < 2; ++t)
#pragma unroll
        for (int g = 0; g < 4; ++g) *(f32x4*)(srow + 32 * t + 8 * g) = (f32x4){sc[t][4 * g], sc[t][4 * g + 1], sc[t][4 * g + 2], sc[t][4 * g + 3]};
}

__device__ __forceinline__ void select_query(const float* score, unsigned* maskw, int t, int lane) {
    const int pos = t % SEQ, n = (pos / CHUNK + 1) * CHUNK;
    unsigned long long* mw = (unsigned long long*)(maskw + (size_t)t * 64);
    if (n <= TOPK) { unsigned long long ones = ~0ull; asm volatile("" : "+v"(ones)); if (lane < n / 64) mw[lane] = ones; return; }
    const int nreg = n / 64;
    unsigned key[32];
    const float* sr = score + (size_t)t * SEQ + lane;
#pragma unroll
    for (int i = 0; i < 32; ++i) { key[i] = 0u;
        if (i < nreg) { const float f = sr[64 * i] + 0.0f; const unsigned u = __float_as_uint(f); key[i] = (u & 0x80000000u) ? ~u : (u | 0x80000000u); } }
    unsigned T = 0u;
    for (int bit = 31; bit >= 0; --bit) {
        const unsigned cand = T | (1u << bit); int cnt = 0;
#pragma unroll
        for (int i = 0; i < 32; ++i) if (i < nreg) cnt += __builtin_popcountll(__ballot(key[i] >= cand));
        if (cnt >= TOPK) T = cand;
    }
    int gt = 0;
#pragma unroll
    for (int i = 0; i < 32; ++i) if (i < nreg) gt += __builtin_popcountll(__ballot(key[i] > T));
    int need = TOPK - gt;
#pragma unroll
    for (int i = 0; i < 32; ++i) if (i < nreg) {
        const unsigned long long eqm = __ballot(key[i] == T), gtm = __ballot(key[i] > T);
        unsigned long long take = gtm;
        if (eqm != 0ull && need > 0) {
            const int ne = __builtin_popcountll(eqm);
            if (ne <= need) { take |= eqm; need -= ne; }
            else { unsigned long long e = eqm; for (int k = 0; k < need; ++k) { const unsigned long long low = e & (~e + 1ull); take |= low; e ^= low; } need = 0; }
        }
        if (lane == 0) mw[i] = take;
    }
}

__device__ __forceinline__ void attn_b_item(const bf16_t* P, const bf16_t* ckvn, const unsigned* maskw, const bf16_t* wuk  , const bf16_t* wuvt  , const float* t5,
                                            bf16_t* cat, int b, int j, int h, int lane, LAS unsigned char* wl, LAS float* tab) {
    const int qpos0 = 32 * j, n = (j / 2 + 1) * CHUNK; const size_t q0 = (size_t)b * SEQ + qpos0;
    const int r32 = lane & 31, hh = lane >> 5, qpos = qpos0 + r32;
    for (int i = lane; i < 229; i += 64) tab[i] = t5[t5_bucket(i - 165) * NT5 + h] * LOG2E;
    const float bfar = t5[15 * NT5 + h] * LOG2E;
    bf16x8 qlf[4][2];
    {
        bf16x8 qf[4]; load_qfrags<4>(P + q0 * LDP + O_QB + h * 64, LDP, lane, qf);
        const float SC = 0.125f * LOG2E;
#pragma unroll
        for (int cb = 0; cb < 4; ++cb) {
            f32x16 X;
#pragma unroll
            for (int r = 0; r < 16; ++r) X[r] = 0.f;
            const bf16_t* wp = wuk + ((size_t)h * B_LAT + 32 * cb + r32) * 64 + 8 * hh;
#pragma unroll
            for (int kk = 0; kk < 4; ++kk) X = MFMA32(*(const bf16x8*)(wp + 16 * kk), qf[kk], X);
            qlf[cb][0] = pack8(X[0] * SC, X[1] * SC, X[2] * SC, X[3] * SC, X[4] * SC, X[5] * SC, X[6] * SC, X[7] * SC);
            qlf[cb][1] = pack8(X[8] * SC, X[9] * SC, X[10] * SC, X[11] * SC, X[12] * SC, X[13] * SC, X[14] * SC, X[15] * SC);
        }
    }
    AttnCore128 core; core.init();
    const bf16_t* Cp = ckvn + (size_t)b * SEQ * B_LAT;
    LDS_WAIT();
    core.dma(Cp, B_LAT, lane, wl);
    const unsigned* mrow = maskw + (q0 + r32) * 64;
    const int krow = pi32(r32);
#pragma unroll 1
    for (int kb = 0; kb < n; kb += 32) {
        const bool has_next = kb + 32 < n;
        const LAS unsigned char* buf = wl + ((kb >> 5) & 1) * AttnCore128::TILE;
        asm volatile("s_waitcnt vmcnt(0)" ::: "memory");
        if (has_next) core.dma(Cp + (size_t)(kb + 32) * B_LAT, B_LAT, lane, wl + (((kb >> 5) + 1) & 1) * AttnCore128::TILE);
        const unsigned mwd = mrow[kb >> 5];
        f32x16 S;
#pragma unroll
        for (int r = 0; r < 16; ++r) S[r] = 0.f;
#pragma unroll
        for (int cb = 0; cb < 4; ++cb)
#pragma unroll
            for (int s = 0; s < 2; ++s) S = MFMA32(*(const LAS bf16x8*)(buf + off128(krow, 4 * cb + 2 * s + hh)), qlf[cb][s], S);
        if (kb + 31 + 166 <= qpos0) {
#pragma unroll
            for (int r = 0; r < 16; ++r) S[r] = ((mwd >> koff(r, hh)) & 1u) ? S[r] + bfar : -1e30f;
        } else {
#pragma unroll
            for (int r = 0; r < 16; ++r) { const int rel = (kb + koff(r, hh)) - qpos; const float tv = tab[rel < -165 ? 0 : rel + 165]; const float bv = rel < -165 ? bfar : tv;
                S[r] = ((mwd >> koff(r, hh)) & 1u) ? S[r] + bv : -1e30f; }
        }
        bf16x8 p0, p1; core.softmax(S, p0, p1);
        core.pv(buf, lane, p0, p1);
        asm volatile("" ::: "memory");
    }
    const float inv = 1.0f / core.lsum();
    f32x16 ot[2];
#pragma unroll
    for (int db = 0; db < 2; ++db) {
#pragma unroll
        for (int r = 0; r < 16; ++r) ot[db][r] = 0.f;
        const bf16_t* wp = wuvt + ((size_t)h * 64 + 32 * db + r32) * B_LAT + 8 * hh;
#pragma unroll
        for (int cb = 0; cb < 4; ++cb) {
            const bf16x8 x0 = pack8(core.o[cb][0], core.o[cb][1], core.o[cb][2], core.o[cb][3], core.o[cb][4], core.o[cb][5], core.o[cb][6], core.o[cb][7]);
            const bf16x8 x1 = pack8(core.o[cb][8], core.o[cb][9], core.o[cb][10], core.o[cb][11], core.o[cb][12], core.o[cb][13], core.o[cb][14], core.o[cb][15]);
            ot[db] = MFMA32(*(const bf16x8*)(wp + 32 * cb), x0, ot[db]);
            ot[db] = MFMA32(*(const bf16x8*)(wp + 32 * cb + 16), x1, ot[db]);
        }
    }
    store_ot<2>(ot, inv, cat + q0 * DM + 512 + h * 64, DM, lane);
    LDS_WAIT();
}

__device__ __forceinline__ void ckvn_row(const bf16_t* P, const float* gain, bf16_t* ckvn, int t, int lane) {
    const unsigned w = *(const unsigned*)(P + (size_t)t * LDP + O_CKV + 2 * lane);
    const float a = bfl(w), bb = bfh(w);
    const float r = 1.0f / sqrtf(wave_sum(a * a + bb * bb) * (1.0f / B_LAT) + EPS);
    const int c = 2 * lane, pc = (c & ~12) | ((c & 4) << 1) | ((c & 8) >> 1);
    *(unsigned*)(ckvn + (size_t)t * B_LAT + pc) = pk2(a * r * gain[c], bb * r * gain[c + 1]);
}

__device__ __forceinline__ float gelu_tanh_fast(float x) {
    const float z = 0.7978845608028654f * (x + 0.044715f * x * x * x);
    return x * __builtin_amdgcn_rcpf(1.0f + __builtin_amdgcn_exp2f(-2.0f * LOG2E * z));
}
__device__ __forceinline__ void conv_item(const bf16_t* u, const float* cw, const float* cb, bf16_t* act, int item, int lane) {
    const int strip = item % 22, seg = item / 22;
    const int c0 = strip * 256 + 4 * lane;
    if (c0 >= DFF) return;
    const int r0 = seg * 32;
    const f32x4 wg0 = *(const f32x4*)(cw + c0), wg1 = *(const f32x4*)(cw + 2 * DFF + c0), wg2 = *(const f32x4*)(cw + 4 * DFF + c0);
    const f32x4 wv0 = *(const f32x4*)(cw + DFF + c0), wv1 = *(const f32x4*)(cw + 3 * DFF + c0), wv2 = *(const f32x4*)(cw + 5 * DFF + c0);
    const f32x4 bg = *(const f32x4*)(cb + c0), bv = *(const f32x4*)(cb + DFF + c0);
    f32x4 g1 = (f32x4){0.f, 0.f, 0.f, 0.f}, g2 = g1, v1 = g1, v2 = g1;
    if ((r0 % SEQ) != 0) {
        const u32x2 a1 = *(const u32x2*)(u + (size_t)(r0 - 1) * (2 * DFF) + c0), a2 = *(const u32x2*)(u + (size_t)(r0 - 2) * (2 * DFF) + c0);
        const u32x2 b1 = *(const u32x2*)(u + (size_t)(r0 - 1) * (2 * DFF) + DFF + c0), b2 = *(const u32x2*)(u + (size_t)(r0 - 2) * (2 * DFF) + DFF + c0);
        g1 = (f32x4){bfl(a1.x), bfh(a1.x), bfl(a1.y), bfh(a1.y)}; g2 = (f32x4){bfl(a2.x), bfh(a2.x), bfl(a2.y), bfh(a2.y)};
        v1 = (f32x4){bfl(b1.x), bfh(b1.x), bfl(b1.y), bfh(b1.y)}; v2 = (f32x4){bfl(b2.x), bfh(b2.x), bfl(b2.y), bfh(b2.y)};
    }
#pragma unroll 4
    for (int r = r0; r < r0 + 32; ++r) {
        const u32x2 a0 = *(const u32x2*)(u + (size_t)r * (2 * DFF) + c0), b0 = *(const u32x2*)(u + (size_t)r * (2 * DFF) + DFF + c0);
        const f32x4 g0 = (f32x4){bfl(a0.x), bfh(a0.x), bfl(a0.y), bfh(a0.y)}, v0 = (f32x4){bfl(b0.x), bfh(b0.x), bfl(b0.y), bfh(b0.y)};
        const f32x4 ga = bg + g2 * wg0 + g1 * wg1 + g0 * wg2, va = bv + v2 * wv0 + v1 * wv1 + v0 * wv2;
        u32x2 w; w.x = pg8::cvt_pk_bf16(gelu_tanh_fast(ga.x) * va.x, gelu_tanh_fast(ga.y) * va.y); w.y = pg8::cvt_pk_bf16(gelu_tanh_fast(ga.z) * va.z, gelu_tanh_fast(ga.w) * va.w);
        *(u32x2*)(act + (size_t)r * DFF + c0) = w;
        g2 = g1; g1 = g0; v2 = v1; v1 = v0;
    }
}

#ifndef REP_G1
#define REP_G1 1
#endif
#ifndef REP_G6
#define REP_G6 1
#endif
#ifndef REP_G10
#define REP_G10 1
#endif
#ifndef REP_G12
#define REP_G12 1
#endif
#ifndef REP_G14
#define REP_G14 1
#endif
#ifndef PROBE_MASK
#define PROBE_MASK 0
#endif
#ifndef REP_G5
#define REP_G5 1
#endif
#ifndef REP_G8
#define REP_G8 1
#endif
#ifndef REP_BAR
#define REP_BAR 1
#endif
#ifndef REP_THIN
#define REP_THIN 1
#endif
#ifndef REP_P0
#define REP_P0 1
#endif
#ifndef REP_P2
#define REP_P2 1
#endif
#ifndef REP_P3
#define REP_P3 1
#endif
#ifndef REP_P4
#define REP_P4 1
#endif
#ifndef REP_P9
#define REP_P9 1
#endif
#ifndef REP_P13
#define REP_P13 1
#endif

struct SchedBranch {
    const bf16_t* A; const bf16_t* Bt; int G, c;
    __device__ __forceinline__ bool next(int i, pg8::Unit& u) const {
        const int seg = i % 3;
        if (i >= 3 * REP_G5) return false;
        if (!pg8::tile_order(MROWS / 256, DM / 256, G, c, 0, u.pm, u.pn)) return false;
        const int k0 = seg == 0 ? 0 : seg == 1 ? 512 : 1024;
        u.nt = seg == 2 ? 16 : 8; u.tag = seg | (seg < 2 ? pg8::TAG_KEEP : 0);
        u.A = (const char*)(A + (size_t)u.pm * 256 * DM + k0); u.B = (const char*)(Bt + (size_t)u.pn * 256 * DM + k0); return true;
    }
};
struct SchedMemProj {
    const bf16_t* H; const bf16_t* WqT; const bf16_t* MemN; const bf16_t* WkvT; int G, c;
    __device__ __forceinline__ bool next(int i, pg8::Unit& u) const {
        const int L = c; if (L >= 80 || i >= REP_G8) return false;
        u.nt = DM / 64;
        if (L < 64) { u.pm = L % 32; u.pn = L / 32; u.tag = 0; u.A = (const char*)(H + (size_t)u.pm * 256 * DM); u.B = (const char*)(WqT + (size_t)u.pn * 256 * DM); }
        else { const int t = L - 64; u.pm = t % 4; u.pn = t / 4; u.tag = 1; u.A = (const char*)(MemN + (size_t)u.pm * 256 * DM); u.B = (const char*)(WkvT + (size_t)u.pn * 256 * DM); }
        return true;
    }
};

__device__ __forceinline__ unsigned char* lds_ptr_entry(LAS unsigned char* lds0, int i) {
    unsigned off = LDSCTL_OFF + 512; asm volatile("" : "+s"(off));
    const unsigned long long v = *(volatile LAS unsigned long long*)(lds0 + off + 8 * i);
    return (unsigned char*)(((unsigned long long)(unsigned)__builtin_amdgcn_readfirstlane((int)(v >> 32)) << 32) | (unsigned long long)(unsigned)__builtin_amdgcn_readfirstlane((int)(v & 0xffffffffull)));
}

__global__ void __launch_bounds__(NWAVES * 64, 2) fwd_kernel(Params p) {
    extern __shared__ __attribute__((aligned(16))) unsigned char lds_raw[];
    Frame F;
    F.lds = (LAS unsigned char*)lds_raw;
    F.tid = threadIdx.x; F.lane = F.tid & 63; F.wave = __builtin_amdgcn_readfirstlane(F.tid >> 6);
    F.G = gridDim.x; { const int bx = blockIdx.x; F.vcu = (F.G % 8 == 0) ? (bx % 8) * (F.G / 8) + bx / 8 : bx; }
    F.gw = F.vcu * NWAVES + F.wave; F.NGW = F.G * NWAVES;
    volatile LAS unsigned* MISC = (volatile LAS unsigned*)(F.lds + MISC_OFF);
    for (int u = F.tid; u < (LDS_BYTES - LDSCTL_OFF) / 4; u += NWAVES * 64) ((LAS unsigned*)(F.lds + LDSCTL_OFF))[u] = 0u;
    __syncthreads();
    volatile LAS unsigned long long* PT = (volatile LAS unsigned long long*)(F.lds + LDSCTL_OFF + 512);
    if (F.tid == 0) {
        PT[0] = (unsigned long long)p.x;
        PT[1] = (unsigned long long)p.mem;
        PT[2] = (unsigned long long)p.t5;
        PT[3] = (unsigned long long)p.gains;
        PT[4] = (unsigned long long)p.w_in;
        PT[5] = (unsigned long long)p.a_rel;
        PT[6] = (unsigned long long)p.ckv_gain;
        PT[7] = (unsigned long long)p.w_uk;
        PT[8] = (unsigned long long)p.w_uv;
        PT[9] = (unsigned long long)p.sinks;
        PT[10] = (unsigned long long)p.w_branch;
        PT[11] = (unsigned long long)p.w_o;
        PT[12] = (unsigned long long)p.mem_gain;
        PT[13] = (unsigned long long)p.w_mq;
        PT[14] = (unsigned long long)p.w_mkv;
        PT[15] = (unsigned long long)p.w_mo;
        PT[16] = (unsigned long long)p.w_up;
        PT[17] = (unsigned long long)p.conv_w;
        PT[18] = (unsigned long long)p.conv_b;
        PT[19] = (unsigned long long)p.w_down;
        PT[20] = (unsigned long long)p.out;
        PT[21] = (unsigned long long)p.ws;
    }
    __syncthreads();
#define PTR(i) lds_ptr_entry(F.lds, (i))
#define ws PTR(21)
    (void)xcd_barrier_post((unsigned*)(ws + WS_CTL) + CW_BAR, MISC + 8);
#define GRID_BAR() do { unsigned char* wsb = ws; asm volatile("" : "+s"(wsb)); XcdBarrier b_; b_.bar = (unsigned*)(wsb + WS_CTL) + CW_BAR; b_.x = xb_xcc_id(); b_.st = MISC + 8; for (int rb_ = 0; rb_ < REP_BAR; ++rb_) xcd_barrier(b_, F.wave == 0 && fresh_lane() == 0); } while (0)
    const int gw0 = F.gw, NGW0 = F.NGW;
#define FRESH_LANE() const int lane = fresh_lane()

#if PROBE_MASK
#define STAMP(kind) do { if (blockIdx.x == 0 && F.wave == 0) { const unsigned long long now_ = __builtin_amdgcn_s_memrealtime(); if (fresh_lane() == 0) { volatile LAS unsigned long long* ts_ = (volatile LAS unsigned long long*)(F.lds + LDSCTL_OFF + 768); \
    if ((PROBE_MASK >> (kind)) & 1) ts_[1] += now_ - ts_[0]; ts_[0] = now_; } } } while (0)
#else
#define STAMP(kind) do { } while (0)
#endif
#define PHASE_BEGIN() unsigned char* wsp = ws; int lp = l_, gw = gw0, NGW = NGW0, wvi = F.wave, Gp = F.G, bxp = (int)blockIdx.x; asm volatile("" : "+s"(wsp), "+s"(lp), "+s"(gw), "+s"(NGW), "+s"(wvi), "+s"(Gp), "+s"(bxp)); LAS unsigned char* wl = F.lds + wvi * WAVE_LDS; (void)wl; (void)gw; (void)NGW; (void)Gp; (void)bxp
#define Hb ((bf16_t*)(wsp + WS_H))
#define Pb ((bf16_t*)(wsp + WS_BIG))
#define CATb ((bf16_t*)(wsp + WS_CAT))
#define QMb CATb
#define OMb (CATb + (size_t)MROWS * MEM_W)
#define MRGb ((bf16_t*)(wsp + WS_MRG))
#define SCOREf ((float*)(wsp + WS_MRG))
#define Yb ((bf16_t*)(wsp + WS_Y))
#define ACTb ((bf16_t*)(wsp + WS_ACT))
#define CKVNb ((bf16_t*)(wsp + WS_CKVN))
#define MASKw ((unsigned*)(wsp + WS_MASK))
#define KVMb ((bf16_t*)(wsp + WS_KVM) + (size_t)lp * 1024 * 1024)
#define WLB (wsp + WS_W0 + (size_t)lp * WL_SIZE)

#if PROBE_MASK
    if (blockIdx.x == 0 && F.tid == 0) { volatile LAS unsigned long long* ts_ = (volatile LAS unsigned long long*)(F.lds + LDSCTL_OFF + 768); ts_[0] = __builtin_amdgcn_s_memrealtime(); ts_[1] = 0ull; }
    __syncthreads();
#endif
    {
        const int l_ = 0; FRESH_LANE(); PHASE_BEGIN(); (void)lp;
        constexpr int I_IN = (DM / 64) * (LDP / 64), I_BR = (DM / 64) * (DM / 64), I_O = I_BR, I_MQ = (DM / 64) * (MEM_W / 64), I_MKV = (DM / 64) * (2 * MEM_W / 64),
                      I_MO = (MEM_W / 64) * (DM / 64), I_UP = (DM / 64) * (2 * DFF / 64), I_DN = (DFF / 64) * (DM / 64);
        constexpr int NPL = I_IN + I_BR + I_O + I_MQ + I_MKV + I_MO + I_UP + I_DN, NITEMS = DEPTH * NPL;
        struct It { const float* W; bf16_t* WT; int K, N, k0, n0, kind; };
        auto decode = [&](int it) -> It {
            It d; const int l = it / NPL; int r = it % NPL; unsigned char* wlb = wsp + WS_W0 + (size_t)l * WL_SIZE; int nblk;
            if (r < I_IN) { d.W = ((const float*)PTR(4)) + (size_t)l * DM * IN_W; d.WT = (bf16_t*)(wlb + WL_IN); d.K = DM; d.N = IN_W; nblk = LDP / 64; d.kind = 1; }
            else if ((r -= I_IN) < I_BR) { d.W = ((const float*)PTR(10)) + (size_t)l * DM * DM; d.WT = (bf16_t*)(wlb + WL_BR); d.K = DM; d.N = DM; nblk = DM / 64; d.kind = 0; }
            else if ((r -= I_BR) < I_O) { d.W = ((const float*)PTR(11)) + (size_t)l * DM * DM; d.WT = (bf16_t*)(wlb + WL_O); d.K = DM; d.N = DM; nblk = DM / 64; d.kind = 0; }
            else if ((r -= I_O) < I_MQ) { d.W = ((const float*)PTR(13)) + (size_t)l * DM * MEM_W; d.WT = (bf16_t*)(wlb + WL_MQ); d.K = DM; d.N = MEM_W; nblk = MEM_W / 64; d.kind = 0; }
            else if ((r -= I_MQ) < I_MKV) { d.W = ((const float*)PTR(14)) + (size_t)l * DM * 2 * MEM_W; d.WT = (bf16_t*)(wlb + WL_MKV); d.K = DM; d.N = 2 * MEM_W; nblk = 2 * MEM_W / 64; d.kind = 0; }
            else if ((r -= I_MKV) < I_MO) { d.W = ((const float*)PTR(15)) + (size_t)l * MEM_W * DM; d.WT = (bf16_t*)(wlb + WL_MO); d.K = MEM_W; d.N = DM; nblk = DM / 64; d.kind = 0; }
            else if ((r -= I_MO) < I_UP) { d.W = ((const float*)PTR(16)) + (size_t)l * DM * 2 * DFF; d.WT = (bf16_t*)(wlb + WL_UP); d.K = DM; d.N = 2 * DFF; nblk = 2 * DFF / 64; d.kind = 0; }
            else { r -= I_UP; d.W = ((const float*)PTR(19)) + (size_t)l * DFF * DM; d.WT = (bf16_t*)(wlb + WL_DN); d.K = DFF; d.N = DM; nblk = DM / 64; d.kind = 0; }
            d.k0 = 64 * (r / nblk); d.n0 = 64 * (r % nblk); return d;
        };
        f32x4 va[16], vb[16];
        int it = gw;
        It cur{}; if (it < REP_P0 * NITEMS) { cur = decode(it % NITEMS); if (cur.kind) tr_load(cur.W, cur.N, cur.k0, cur.n0, lane, CsIn(), va); else tr_load(cur.W, cur.N, cur.k0, cur.n0, lane, CsId(), va); }
        while (it < REP_P0 * NITEMS) {
            const int itn = it + NGW; It nx{};
            if (itn < REP_P0 * NITEMS) { nx = decode(itn % NITEMS); if (nx.kind) tr_load(nx.W, nx.N, nx.k0, nx.n0, lane, CsIn(), vb); else tr_load(nx.W, nx.N, nx.k0, nx.n0, lane, CsId(), vb); }
            tr_store(cur.WT, cur.K, cur.k0, cur.n0, lane, wl, va);
            it = itn; if (it >= REP_P0 * NITEMS) break;
            const int itn2 = it + NGW; cur = nx;
            if (itn2 < REP_P0 * NITEMS) { nx = decode(itn2 % NITEMS); if (nx.kind) tr_load(nx.W, nx.N, nx.k0, nx.n0, lane, CsIn(), va); else tr_load(nx.W, nx.N, nx.k0, nx.n0, lane, CsId(), va); }
            tr_store(cur.WT, cur.K, cur.k0, cur.n0, lane, wl, vb);
            it = itn2; cur = nx;
        }
        const int gt = gw * 64 + lane, NGT = NGW * 64;
        for (int i = gt; i < DEPTH * 8 * 128 * 64; i += NGT) {
            ((bf16_t*)(wsp + WS_WUK))[i] = (bf16_t)f2bf(((const float*)PTR(7))[i]);
            const int c = i & 127, d = (i >> 7) & 63, lh = i >> 13;
            ((bf16_t*)(wsp + WS_WUVT))[i] = (bf16_t)f2bf(((const float*)PTR(8))[((size_t)lh * 128 + c) * 64 + d]);
        }
        for (int r = gw; r < DEPTH * NBATCH * MEM_LEN; r += NGW) { const int l = r / (NBATCH * MEM_LEN), mr = r % (NBATCH * MEM_LEN);
            rms_row_to_bf16(((const float*)PTR(1)) + (size_t)mr * DM, ((const float*)PTR(12)) + (size_t)l * DM, (bf16_t*)(wsp + WS_MEMN) + (size_t)r * DM, lane); }
        for (int r = gw; r < MROWS; r += NGW) rms_row_to_bf16(((const float*)PTR(0)) + (size_t)r * DM, ((const float*)PTR(3)), Hb + (size_t)r * DM, lane);
    }
    GRID_BAR(); STAMP(0);

    for (int l_ = 0; l_ < DEPTH; ++l_) {
        {
            PHASE_BEGIN();
            pg8::SchedGrid S{Hb, (const bf16_t*)(WLB + WL_IN), MROWS / 256, LDP / 256, DM, Gp, bxp, REP_G1};
            pg8::EpiStore E{Pb, LDP, O_GL / 256, nullptr, 0};
            pg8::gemm_phase(F.lds, DM, S, E, wvi, fresh_lane());
        }
        GRID_BAR(); STAMP(1);
        {
            FRESH_LANE(); PHASE_BEGIN();
            const float* relb = ((const float*)PTR(5)) + (size_t)lp * (2 * A_MAXREL + 1) * A_HEADS;
            for (int it = gw; it < REP_P2 * NBATCH * 32 * A_HEADS * 2; it += NGW) attn_a_item(Pb, relb, CATb, it % (NBATCH * 32 * A_HEADS * 2), lane, wl);
            for (int it = gw; it < REP_P2 * NBATCH * 32 * C_QH * 2; it += NGW) attn_c_item(Pb, ((const float*)PTR(2)), ((const float*)PTR(9)) + (size_t)lp * C_QH, CATb, it % (NBATCH * 32 * C_QH * 2), lane, wl);
            for (int it = gw; it < REP_P2 * NBATCH * 528 * 2; it += NGW) idx_score_item(Pb, SCOREf, it % (NBATCH * 528 * 2), lane);
            for (int t = gw; t < MROWS; t += NGW) ckvn_row(Pb, ((const float*)PTR(6)) + (size_t)lp * B_LAT, CKVNb, t, lane);
        }
        GRID_BAR(); STAMP(2);
        { FRESH_LANE(); PHASE_BEGIN(); const float* g = ((const float*)PTR(3)) + (size_t)lp * 6 * DM; (void)g;
        for (int q_ = gw; q_ < REP_P3 * 2048; q_ += NGW) { const int q = q_ & 2047;
            const int pp = q & 1023, bp = q >> 10;
            select_query(SCOREf, MASKw, (2 * bp) * SEQ + pp, lane); select_query(SCOREf, MASKw, (2 * bp) * SEQ + (SEQ - 1 - pp), lane);
            select_query(SCOREf, MASKw, (2 * bp + 1) * SEQ + pp, lane); select_query(SCOREf, MASKw, (2 * bp + 1) * SEQ + (SEQ - 1 - pp), lane);
        } }
        GRID_BAR(); STAMP(3);
        { FRESH_LANE(); PHASE_BEGIN(); const float* g = ((const float*)PTR(3)) + (size_t)lp * 6 * DM; (void)g;
        for (int q_ = gw; q_ < REP_P4 * 2048; q_ += NGW) { const int q = q_ & 2047;
            const int wv = q & 7, gq = q >> 3, pr = gq * 4 + (wv & 3), b = pr >> 8, rem = pr & 255, jj = rem >> 3, h = rem & 7, j = (wv >> 2) ? 63 - jj : jj;
            attn_b_item(Pb, CKVNb, MASKw, (const bf16_t*)(wsp + WS_WUK) + (size_t)lp * 8 * 128 * 64, (const bf16_t*)(wsp + WS_WUVT) + (size_t)lp * 8 * 128 * 64, ((const float*)PTR(2)), CATb, b, j, h, lane, wl, (LAS float*)(F.lds + LDSCTL_OFF + 1024 + wvi * 1280));
        } }
        GRID_BAR(); STAMP(4);
        {
            PHASE_BEGIN();
            SchedBranch S{CATb, (const bf16_t*)(WLB + WL_BR), Gp, bxp};
            pg8::EpiBranch E{Pb + O_GL, LDP, MRGb, DM};
            pg8::gemm_phase(F.lds, DM, S, E, wvi, fresh_lane());
        }
        GRID_BAR(); STAMP(5);
        {
            PHASE_BEGIN();
            pg8::SchedGrid S{MRGb, (const bf16_t*)(WLB + WL_O), MROWS / 256, DM / 256, DM, Gp, bxp, REP_G6};
            pg8::EpiStore E{Yb, DM, 1 << 30, nullptr, 0};
            pg8::gemm_phase(F.lds, DM, S, E, wvi, fresh_lane());
        }
        GRID_BAR(); STAMP(6);
        { FRESH_LANE(); PHASE_BEGIN(); const float* g = ((const float*)PTR(3)) + (size_t)lp * 6 * DM; (void)g;
        if (REP_THIN > 1) for (int r = gw; r < MROWS; r += NGW) resnorm_row(((float*)PTR(20)) + (size_t)r * DM, Yb + (size_t)r * DM, g + DM, (float*)Pb + (size_t)r * DM, g + 2 * DM, (bf16_t*)((float*)Pb + (size_t)MROWS * DM) + (size_t)r * DM, lane);
        for (int r = gw; r < MROWS; r += NGW) resnorm_row((lp == 0 ? ((const float*)PTR(0)) : ((float*)PTR(20))) + (size_t)r * DM, Yb + (size_t)r * DM, g + DM, ((float*)PTR(20)) + (size_t)r * DM, g + 2 * DM, Hb + (size_t)r * DM, lane); }
        GRID_BAR(); STAMP(7);
        {
            PHASE_BEGIN();
            SchedMemProj S{Hb, (const bf16_t*)(WLB + WL_MQ), (const bf16_t*)(wsp + WS_MEMN) + (size_t)lp * 1024 * DM, (const bf16_t*)(WLB + WL_MKV), Gp, bxp};
            pg8::EpiStore E{QMb, MEM_W, 1 << 30, KVMb, 2 * MEM_W};
            pg8::gemm_phase(F.lds, DM, S, E, wvi, fresh_lane());
        }
        GRID_BAR(); STAMP(8);
        { FRESH_LANE(); PHASE_BEGIN(); for (int it = gw; it < REP_P9 * NBATCH * 64 * MEM_HEADS; it += NGW) attn_mem_item(QMb, KVMb, OMb, it % (NBATCH * 64 * MEM_HEADS), lane, wl); }
        GRID_BAR(); STAMP(9);
        {
            PHASE_BEGIN();
            pg8::SchedGrid S{OMb, (const bf16_t*)(WLB + WL_MO), MROWS / 256, DM / 256, MEM_W, Gp, bxp, REP_G10};
            pg8::EpiStore E{Yb, DM, 1 << 30, nullptr, 0};
            pg8::gemm_phase(F.lds, MEM_W, S, E, wvi, fresh_lane());
        }
        GRID_BAR(); STAMP(10);
        { FRESH_LANE(); PHASE_BEGIN(); const float* g = ((const float*)PTR(3)) + (size_t)lp * 6 * DM; (void)g;
        if (REP_THIN > 1) for (int r = gw; r < MROWS; r += NGW) resnorm_row(((float*)PTR(20)) + (size_t)r * DM, Yb + (size_t)r * DM, g + DM, (float*)Pb + (size_t)r * DM, g + 2 * DM, (bf16_t*)((float*)Pb + (size_t)MROWS * DM) + (size_t)r * DM, lane);
        for (int r = gw; r < MROWS; r += NGW) resnorm_row(((float*)PTR(20)) + (size_t)r * DM, Yb + (size_t)r * DM, g + 3 * DM, ((float*)PTR(20)) + (size_t)r * DM, g + 4 * DM, Hb + (size_t)r * DM, lane); }
        GRID_BAR(); STAMP(11);
        {
            PHASE_BEGIN();
            pg8::SchedGrid S{Hb, (const bf16_t*)(WLB + WL_UP), MROWS / 256, 2 * DFF / 256, DM, Gp, bxp, REP_G12};
            pg8::EpiStore E{Pb, 2 * DFF, 1 << 30, nullptr, 0};
            pg8::gemm_phase(F.lds, DM, S, E, wvi, fresh_lane());
        }
        GRID_BAR(); STAMP(12);
        { FRESH_LANE(); PHASE_BEGIN(); for (int it = gw; it < REP_P13 * 22 * (MROWS / 32); it += NGW) conv_item(Pb, ((const float*)PTR(17)) + (size_t)lp * 3 * 2 * DFF, ((const float*)PTR(18)) + (size_t)lp * 2 * DFF, ACTb, it % (22 * (MROWS / 32)), lane); }
        GRID_BAR(); STAMP(13);
        {
            PHASE_BEGIN();
            pg8::SchedGrid S{ACTb, (const bf16_t*)(WLB + WL_DN), MROWS / 256, DM / 256, DFF, Gp, bxp, REP_G14};
            pg8::EpiStore E{Yb, DM, 1 << 30, nullptr, 0};
            pg8::gemm_phase(F.lds, DFF, S, E, wvi, fresh_lane());
        }
        GRID_BAR(); STAMP(14);
        {
            FRESH_LANE(); PHASE_BEGIN(); const float* g = ((const float*)PTR(3)) + (size_t)lp * 6 * DM;
            const float* gn = ((const float*)PTR(3)) + (size_t)(lp + 1 < DEPTH ? lp + 1 : lp) * 6 * DM;
            if (REP_THIN > 1) for (int r = gw; r < MROWS; r += NGW) resnorm_row(((float*)PTR(20)) + (size_t)r * DM, Yb + (size_t)r * DM, g + DM, (float*)Pb + (size_t)r * DM, g + 2 * DM, (bf16_t*)((float*)Pb + (size_t)MROWS * DM) + (size_t)r * DM, lane);
            for (int r = gw; r < MROWS; r += NGW) resnorm_row(((float*)PTR(20)) + (size_t)r * DM, Yb + (size_t)r * DM, g + 5 * DM, ((float*)PTR(20)) + (size_t)r * DM, gn, (lp + 1 < DEPTH) ? Hb + (size_t)r * DM : nullptr, lane);
        }
        if (l_ + 1 < DEPTH) GRID_BAR();
        else { asm volatile("s_waitcnt vmcnt(0)" ::: "memory"); __syncthreads(); }
        STAMP(15);
    }
#if PROBE_MASK
    if (blockIdx.x == 0 && F.tid == 0) { volatile LAS unsigned long long* ts_ = (volatile LAS unsigned long long*)(F.lds + LDSCTL_OFF + 768); ((float*)PTR(20))[0] = (float)ts_[1] * 0.1f; }
#endif
}

#undef ws
#undef PTR
extern "C" void kernel_launch(void* const* d_in, const int* in_sizes, int n_in, void* d_out, int out_size, void* d_ws, size_t ws_size, hipStream_t stream) {
    static int grid = 0;
    if (grid == 0) {
        if (n_in != 20 || in_sizes[0] != MROWS * DM || out_size != MROWS * DM || ws_size < WS_END) {
            fprintf(stderr, "kernel_launch: unexpected problem (n_in %d, in0 %d, out %d, ws %zu, need %zu); nothing launched\n", n_in, n_in > 0 ? in_sizes[0] : -1, out_size, ws_size, (size_t)WS_END); grid = -1; return; }
        int dev = 0, cus = 0, per_cu = 0;
        if (hipGetDevice(&dev) != hipSuccess || hipDeviceGetAttribute(&cus, hipDeviceAttributeMultiprocessorCount, dev) != hipSuccess) { fprintf(stderr, "kernel_launch: device query failed\n"); grid = -1; return; }
        if (hipFuncSetAttribute((const void*)fwd_kernel, hipFuncAttributeMaxDynamicSharedMemorySize, LDS_BYTES) != hipSuccess) { fprintf(stderr, "kernel_launch: hipFuncSetAttribute failed\n"); grid = -1; return; }
        if (hipOccupancyMaxActiveBlocksPerMultiprocessor(&per_cu, (const void*)fwd_kernel, NWAVES * 64, LDS_BYTES) != hipSuccess || per_cu < 1)
            fprintf(stderr, "kernel_launch: note: the occupancy query reports %d workgroups per CU\n", per_cu);
        (void)hipGetLastError();
        grid = cus;
    }
    if (grid < 0) return;
    if (hipMemsetAsync((char*)d_ws + WS_CTL, 0, CTL_ZERO_BYTES, stream) != hipSuccess) { fprintf(stderr, "kernel_launch: memset failed\n"); return; }
    Params p{};
    p.x = (const float*)d_in[0]; p.mem = (const float*)d_in[1]; p.t5 = (const float*)d_in[2]; p.gains = (const float*)d_in[3]; p.w_in = (const float*)d_in[4];
    p.a_rel = (const float*)d_in[5]; p.ckv_gain = (const float*)d_in[6]; p.w_uk = (const float*)d_in[7]; p.w_uv = (const float*)d_in[8]; p.sinks = (const float*)d_in[9];
    p.w_branch = (const float*)d_in[10]; p.w_o = (const float*)d_in[11]; p.mem_gain = (const float*)d_in[12]; p.w_mq = (const float*)d_in[13]; p.w_mkv = (const float*)d_in[14];
    p.w_mo = (const float*)d_in[15]; p.w_up = (const float*)d_in[16]; p.conv_w = (const float*)d_in[17]; p.conv_b = (const float*)d_in[18]; p.w_down = (const float*)d_in[19];
    p.out = (float*)d_out; p.ws = (unsigned char*)d_ws;
    hipLaunchKernelGGL(fwd_kernel, dim3(grid), dim3(NWAVES * 64), LDS_BYTES, stream, p);
    const hipError_t le = hipPeekAtLastError();
    if (le != hipSuccess) fprintf(stderr, "kernel_launch: launch failed: %s\n", hipGetErrorName(le));
}
```
